# Optimizing an MI355X kernel written in HIP

```python
import jax, jax.numpy as jnp
from jax import lax
import numpy as np


D_MODEL = 1024
BATCH = 8
SEQ = 8192
DEPTH = 1

MLA_HEADS = 8
MLA_Q_LORA = 256
MLA_KV_LORA = 128
MLA_NOPE = 64
MLA_ROPE = 32
MLA_QK = MLA_NOPE + MLA_ROPE
MLA_V = 64
ROPE_THETA = 10000.0
Q_BLOCK = 128
HG_HEADS = 4
HG_DK = 128
HG_DV = 128
HG_CHUNK = 64
MIX_WIDTH = MLA_HEADS * MLA_V + HG_HEADS * HG_DV
IN_SIZES = (MLA_Q_LORA, MLA_KV_LORA, MLA_ROPE,
            HG_HEADS * HG_DK, HG_HEADS * HG_DK, HG_HEADS * HG_DK,
            HG_HEADS * HG_DV, HG_HEADS * HG_DV)
N_IN = MLA_Q_LORA + MLA_KV_LORA + MLA_ROPE + 3 * HG_HEADS * HG_DK + 2 * HG_HEADS * HG_DV
N_GROUPS = 4
EXPERTS_PER_GROUP = 8
N_EXPERTS = N_GROUPS * EXPERTS_PER_GROUP
TOP_K = 2
D_EXPERT = 256
MOE_BLOCK = 256
EPS = 1e-6

kernel_name = "hybrid_mla_hgrn2_hiermoe_encoder"


def rms_norm(x, gain):
    xf = x.astype(jnp.float32)
    y = xf * lax.rsqrt(jnp.mean(xf * xf, axis=-1, keepdims=True) + EPS)
    return (y * gain.astype(jnp.float32)).astype(x.dtype)


def split_cols(t, sizes):
    out, off = [], 0
    for s in sizes:
        out.append(t[..., off:off + s])
        off += s
    return out


def rope(x, pos):
    half = x.shape[-1] // 2
    inv = 1.0 / (ROPE_THETA ** (jnp.arange(half, dtype=jnp.float32) / half))
    ang = pos.astype(jnp.float32)[:, None] * inv[None, :]
    cos = jnp.cos(ang)[:, None, :]
    sin = jnp.sin(ang)[:, None, :]
    xf = x.astype(jnp.float32)
    x1, x2 = xf[..., :half], xf[..., half:]
    return jnp.concatenate([x1 * cos - x2 * sin, x2 * cos + x1 * sin], -1).astype(x.dtype)


def mla_mixer(q_lat, kv_lat, k_rope, q_lat_norm, kv_lat_norm, w_uq, w_ukv, q_norm, k_norm):
    B, S, _ = q_lat.shape
    H = MLA_HEADS
    q = (rms_norm(q_lat, q_lat_norm) @ w_uq).reshape(B, S, H, MLA_QK)
    kv = (rms_norm(kv_lat, kv_lat_norm) @ w_ukv).reshape(B, S, H, MLA_NOPE + MLA_V)
    k_nope, v = kv[..., :MLA_NOPE], kv[..., MLA_NOPE:]
    k = jnp.concatenate([k_nope, jnp.broadcast_to(k_rope[:, :, None, :], (B, S, H, MLA_ROPE))], -1)
    q = rms_norm(q, q_norm)
    k = rms_norm(k, k_norm)
    pos = jnp.arange(S)
    q = jnp.concatenate([q[..., :MLA_NOPE], rope(q[..., MLA_NOPE:], pos)], -1)
    k = jnp.concatenate([k[..., :MLA_NOPE], rope(k[..., MLA_NOPE:], pos)], -1)
    q = q * (MLA_QK ** -0.5)
    qb = q.reshape(B, S // Q_BLOCK, Q_BLOCK, H, MLA_QK).transpose(1, 0, 2, 3, 4)

    def attend(q_blk):
        s = jnp.einsum('bqhd,bkhd->bhqk', q_blk, k, preferred_element_type=jnp.float32)
        p = jax.nn.softmax(s, axis=-1).astype(v.dtype)
        return jnp.einsum('bhqk,bkhd->bqhd', p, v)

    o = lax.map(attend, qb)
    return o.transpose(1, 0, 2, 3, 4).reshape(B, S, H * MLA_V)


def hgrn2_mixer(hq, f_fwd, f_bwd, hi, hg, lb_logits, layer, out_norm):
    B, S, _ = hq.shape
    H, C = HG_HEADS, HG_CHUNK
    NC = S // C
    lb = jnp.cumsum(jax.nn.softmax(lb_logits.astype(jnp.float32), axis=0), axis=0)[layer]
    lb = lb[:, None, None, :]
    z = jnp.stack([f_fwd, jnp.flip(f_bwd, 1)]).astype(jnp.float32)
    f = lb + (1.0 - lb) * jax.nn.sigmoid(z)
    log_f = jnp.log(f)
    k = (1.0 - lb) * jax.nn.sigmoid(-z)
    qf = jax.nn.silu(hq.astype(jnp.float32))
    vf = hi.astype(jnp.float32)
    q = jnp.stack([qf, jnp.flip(qf, 1)])
    v = jnp.stack([vf, jnp.flip(vf, 1)])

    def to_chunks(t, d):
        return t.reshape(2, B, NC, C, H, d).transpose(2, 0, 1, 4, 3, 5)

    qc, kc, vc, gc = to_chunks(q, HG_DK), to_chunks(k, HG_DK), to_chunks(v, HG_DV), to_chunks(log_f, HG_DK)
    causal_in_scan = jnp.tril(jnp.ones((C, C), dtype=bool))[:, :, None]

    def step(state, inp):
        q_t, k_t, v_t, g_t = inp
        b = jnp.cumsum(g_t, axis=-2)
        o_inter = jnp.einsum('zbhtd,zbhde->zbhte', q_t * jnp.exp(b), state)
        diff = b[..., :, None, :] - b[..., None, :, :]
        decay = jnp.exp(jnp.where(causal_in_scan, diff, -jnp.inf))
        a = jnp.einsum('zbhtd,zbhsd,zbhtsd->zbhts', q_t, k_t, decay)
        o_intra = jnp.einsum('zbhts,zbhse->zbhte', a, v_t)
        b_last = b[..., -1:, :]
        new_state = jnp.exp(b_last[..., 0, :])[..., None] * state + \
            jnp.einsum('zbhsd,zbhse->zbhde', k_t * jnp.exp(b_last - b), v_t)
        return new_state, o_inter + o_intra

    s0 = jnp.zeros((2, B, H, HG_DK, HG_DV), jnp.float32)
    _, o = lax.scan(step, s0, (qc, kc, vc, gc))
    o = o.transpose(1, 2, 0, 4, 3, 5).reshape(2, B, S, H, HG_DV)
    o = o[0] + jnp.flip(o[1], axis=1)
    o = rms_norm(o, out_norm) * jax.nn.silu(hg.reshape(B, S, H, HG_DV).astype(jnp.float32))
    return o.reshape(B, S, H * HG_DV).astype(hq.dtype)


def hier_moe(h, w_group, b_group, w_router, b_router, w_gate, w_up, w_down):
    B, S, D = h.shape
    T = B * S
    M = T * TOP_K
    x = h.reshape(T, D)
    g_prob = jax.nn.softmax((x @ w_group).astype(jnp.float32) + b_group.astype(jnp.float32), axis=-1)
    g_w, g_idx = lax.top_k(g_prob, 1)
    e_logits = ((x @ w_router).astype(jnp.float32) + b_router.astype(jnp.float32)).reshape(T, N_GROUPS, EXPERTS_PER_GROUP)
    e_logits = jnp.take_along_axis(e_logits, g_idx[:, :, None], axis=1)[:, 0]
    e_w, e_idx = lax.top_k(jax.nn.softmax(e_logits, axis=-1), TOP_K)
    e_w = e_w / jnp.sum(e_w, axis=-1, keepdims=True)
    gate = (g_w * e_w).astype(h.dtype).reshape(-1)
    eid = (g_idx * EXPERTS_PER_GROUP + e_idx).reshape(-1)
    tok = jnp.repeat(jnp.arange(T, dtype=jnp.int32), TOP_K)
    order = jnp.argsort(eid)
    eid_s, tok_s, gate_s = eid[order], tok[order], gate[order]
    counts = jnp.bincount(eid, length=N_EXPERTS)
    starts = jnp.cumsum(counts) - counts
    padded = (counts + MOE_BLOCK - 1) // MOE_BLOCK * MOE_BLOCK
    pend = jnp.cumsum(padded)
    pstart = pend - padded
    dest = pstart[eid_s] + (jnp.arange(M) - starts[eid_s])
    P = -(-M // MOE_BLOCK) * MOE_BLOCK + N_EXPERTS * MOE_BLOCK
    NB = P // MOE_BLOCK
    tok_buf = jnp.zeros((P,), jnp.int32).at[dest].set(tok_s)
    gate_buf = jnp.zeros((P,), h.dtype).at[dest].set(gate_s)
    block_e = jnp.minimum(jnp.searchsorted(pend, jnp.arange(NB) * MOE_BLOCK, side='right'), N_EXPERTS - 1)
    xb = x[tok_buf].reshape(NB, MOE_BLOCK, D)

    def expert_block(args):
        x_blk, e = args
        return (jax.nn.silu(x_blk @ w_gate[e]) * (x_blk @ w_up[e])) @ w_down[e]

    yb = lax.map(expert_block, (xb, block_e))
    y = jnp.zeros((T, D), h.dtype).at[tok_buf].add(yb.reshape(P, D) * gate_buf[:, None])
    return y.reshape(B, S, D)


def setup_inputs(seed: int = 0) -> dict:
    key = jax.random.key(seed)
    ks = jax.random.split(key, 24)
    f32 = jnp.float32
    L = DEPTH

    def nrm(k, shape, fan_in):
        return jax.random.normal(k, shape, f32) * (fan_in ** -0.5)

    def gain(k, shape):
        return 1.0 + 0.02 * jax.random.normal(k, shape, f32)

    return {
        "x": jax.random.normal(ks[0], (BATCH, SEQ, D_MODEL), f32),
        "norm_mix": gain(ks[1], (L, D_MODEL)),
        "w_in": nrm(ks[2], (L, D_MODEL, N_IN), D_MODEL),
        "q_lat_norm": gain(ks[3], (L, MLA_Q_LORA)),
        "kv_lat_norm": gain(ks[4], (L, MLA_KV_LORA)),
        "w_uq": nrm(ks[5], (L, MLA_Q_LORA, MLA_HEADS * MLA_QK), MLA_Q_LORA),
        "w_ukv": nrm(ks[6], (L, MLA_KV_LORA, MLA_HEADS * (MLA_NOPE + MLA_V)), MLA_KV_LORA),
        "q_norm": gain(ks[7], (L, MLA_QK)),
        "k_norm": gain(ks[8], (L, MLA_QK)),
        "lb_logits": 0.1 * jax.random.normal(ks[9], (DEPTH + 1, 2, HG_HEADS * HG_DK), f32),
        "hg_out_norm": gain(ks[10], (L, HG_DV)),
        "w_out": nrm(ks[11], (L, MIX_WIDTH, D_MODEL), MIX_WIDTH),
        "norm_ffn": gain(ks[12], (L, D_MODEL)),
        "w_group": nrm(ks[13], (L, D_MODEL, N_GROUPS), D_MODEL),
        "b_group": 0.01 * jax.random.normal(ks[14], (L, N_GROUPS), f32),
        "w_router": nrm(ks[15], (L, D_MODEL, N_EXPERTS), D_MODEL),
        "b_router": 0.01 * jax.random.normal(ks[16], (L, N_EXPERTS), f32),
        "w_gate": nrm(ks[17], (L, N_EXPERTS, D_MODEL, D_EXPERT), D_MODEL),
        "w_up": nrm(ks[18], (L, N_EXPERTS, D_MODEL, D_EXPERT), D_MODEL),
        "w_down": nrm(ks[19], (L, N_EXPERTS, D_EXPERT, D_MODEL), D_EXPERT),
    }


def reference(x, norm_mix, w_in, q_lat_norm, kv_lat_norm, w_uq, w_ukv, q_norm, k_norm,
              lb_logits, hg_out_norm, w_out, norm_ffn, w_group, b_group, w_router, b_router,
              w_gate, w_up, w_down):
    h = x
    for l in range(DEPTH):
        n = rms_norm(h, norm_mix[l])
        proj = n @ w_in[l]
        q_lat, kv_lat, k_rope, hq, f_fwd, f_bwd, hi, hg = split_cols(proj, IN_SIZES)
        a = mla_mixer(q_lat, kv_lat, k_rope, q_lat_norm[l], kv_lat_norm[l], w_uq[l], w_ukv[l],
                      q_norm[l], k_norm[l])
        r = hgrn2_mixer(hq, f_fwd, f_bwd, hi, hg, lb_logits, l, hg_out_norm[l])
        h = h + jnp.concatenate([a, r], axis=-1) @ w_out[l]
        h = h + hier_moe(rms_norm(h, norm_ffn[l]), w_group[l], b_group[l], w_router[l], b_router[l],
                         w_gate[l], w_up[l], w_down[l])
    return h
```

```cpp
#include <hip/hip_runtime.h>
#include <hip/hip_cooperative_groups.h>
#include <cstdio>
#include <cstdint>
namespace cg = cooperative_groups;

#ifndef ENABLE_ATTN
#define ENABLE_ATTN 1
#endif
#ifndef ENABLE_HGRN
#define ENABLE_HGRN 1
#endif
#ifndef ENABLE_MOE
#define ENABLE_MOE 1
#endif

#define LAS __attribute__((address_space(3)))
typedef unsigned short bf16_t;
typedef short bf16x8 __attribute__((ext_vector_type(8)));
typedef short s16x4 __attribute__((ext_vector_type(4)));
typedef float f32x2 __attribute__((ext_vector_type(2)));
typedef float f32x4 __attribute__((ext_vector_type(4)));
typedef float f32x8 __attribute__((ext_vector_type(8)));
typedef float f32x16 __attribute__((ext_vector_type(16)));
typedef unsigned u32x2 __attribute__((ext_vector_type(2)));
typedef unsigned u32x4 __attribute__((ext_vector_type(4)));
typedef int i32x4 __attribute__((ext_vector_type(4)));
typedef int i32x8 __attribute__((ext_vector_type(8)));

constexpr int BATCH = 8, SEQ = 8192, DM = 1024, T = BATCH * SEQ;
constexpr int NH = 8, QLORA = 256, KVLORA = 128, DROPE = 32, DNOPE = 64, DQK = 96, DVH = 64;
constexpr int HGH = 4, HDK = 128, HDV = 128, NCHUNK = SEQ / 64;
constexpr int N_IN = 2976, NP = 3072;
constexpr int C_HQ = 512, C_FF = 1024, C_FB = 1536, C_HI = 2048, C_HG = 2560, C_KVL = 256, C_KR = 384;
constexpr int NEXP = 32, DEXP = 256, NBUCKET = 112, MAXTILES = 384;
constexpr float EPS = 1e-6f;
constexpr float WD_SCALE = 16.f, H_SCALE = 16.f;
constexpr float WGU_SCALE = 32.f;
constexpr float QS2 = 0.38372444f;
constexpr float QSCALE = 0.10206207261596577f * 1.4426950408889634f;

constexpr size_t MiB = 1u << 20;
constexpr size_t WS_CNT = 0;
constexpr size_t WS_ZROW = 256 * 1024;
constexpr size_t WS_OML = 768 * 1024;
constexpr size_t WS_BAR = 512 * 1024;
constexpr size_t WS_WIN = 1 * MiB;
constexpr size_t WS_WUQ = 7 * MiB;
constexpr size_t WS_WUKV = WS_WUQ + 512 * 1024;
constexpr size_t WS_WOUT = 8 * MiB;
constexpr size_t WS_WGU = 10 * MiB;
constexpr size_t WS_WD = 42 * MiB;
constexpr size_t WS_ROPE = 58 * MiB;
constexpr size_t WS_EV = 59 * MiB;
constexpr size_t WS_LIST = 67 * MiB;
constexpr size_t WS_GATE = 95 * MiB;
constexpr size_t WS_SLOT = 96 * MiB;
constexpr size_t WS_WR = 98 * MiB;
constexpr size_t WS_R1 = 100 * MiB;
constexpr size_t WS_R2 = 228 * MiB;
constexpr size_t WS_R3 = 612 * MiB;
constexpr size_t WS_R4 = 868 * MiB;
constexpr size_t WS_END = 996 * MiB;
constexpr int MAXSLOTS = 98304;

constexpr int LDS_BYTES = 143360;
constexpr int LDS_BARST = 143360 - 64;
constexpr int LDS_TAB = 131072;

struct Params {
  const float* x; const float* norm_mix; const float* w_in; const float* q_lat_norm; const float* kv_lat_norm; const float* w_uq; const float* w_ukv;
  const float* q_norm; const float* k_norm; const float* lb_logits; const float* hg_out_norm; const float* w_out; const float* norm_ffn;
  const float* w_group; const float* b_group; const float* w_router; const float* b_router; const float* w_gate; const float* w_up; const float* w_down;
  float* out; unsigned char* ws;
};

typedef float f32x2_t_ __attribute__((ext_vector_type(2))); typedef __bf16 bf16x2_t_ __attribute__((ext_vector_type(2)));
__device__ __forceinline__ unsigned cvt_pk_bf16(float lo, float hi) { f32x2_t_ v = {lo, hi}; bf16x2_t_ b = __builtin_convertvector(v, bf16x2_t_); return __builtin_bit_cast(unsigned, b); }
__device__ __forceinline__ float bf2f(unsigned short b) { return __uint_as_float(((unsigned)b) << 16); }
__device__ __forceinline__ unsigned pk4_fp8(float a, float b, float c, float d) { int w = 0;
  a = __builtin_amdgcn_fmed3f(a, -448.f, 448.f); b = __builtin_amdgcn_fmed3f(b, -448.f, 448.f); c = __builtin_amdgcn_fmed3f(c, -448.f, 448.f); d = __builtin_amdgcn_fmed3f(d, -448.f, 448.f);
  w = __builtin_amdgcn_cvt_pk_fp8_f32(a, b, w, false); w = __builtin_amdgcn_cvt_pk_fp8_f32(c, d, w, true); return (unsigned)w; }
__device__ __forceinline__ unsigned pk4_bf8(float a, float b, float c, float d) { int w = 0; w = __builtin_amdgcn_cvt_pk_bf8_f32(a, b, w, false); w = __builtin_amdgcn_cvt_pk_bf8_f32(c, d, w, true); return (unsigned)w; }
__device__ __forceinline__ float bflo(unsigned w) { return __uint_as_float(w << 16); }
__device__ __forceinline__ float bfhi(unsigned w) { return __uint_as_float(w & 0xffff0000u); }
__device__ __forceinline__ unsigned short f2bf(float f) { return (unsigned short)(cvt_pk_bf16(f, 0.f) & 0xffffu); }
__device__ __forceinline__ int crow(int r, int hi) { return (r & 3) + 8 * (r >> 2) + 4 * hi; }
__device__ __forceinline__ float wave_sum(float v) {
#pragma unroll
  for (int o = 1; o < 64; o <<= 1) v += __shfl_xor(v, o);
  return v;
}
__device__ __forceinline__ float sigmoidf_(float x) { return __builtin_amdgcn_rcpf(1.f + __expf(-x)); }
__device__ __forceinline__ int otid() { int t = threadIdx.x; asm volatile("" : "+v"(t)); return t; }
#define LDS_WAIT() asm volatile("s_waitcnt lgkmcnt(0)" ::: "memory")
#define VM_WAIT() asm volatile("s_waitcnt vmcnt(0)" ::: "memory")
#define SBAR() __builtin_amdgcn_sched_barrier(0)

namespace pg8 {
constexpr int PG8_VOOFF = 131072 + 3072;
constexpr int BM = 256, BK = 64, HALF = 128, HTB = HALF * BK * 2, STAGE_BYTES = 8 * HTB, NXCD = 8, WGM = 4;
__host__ __device__ __forceinline__ int lds_byte(int r, int c) { const int st = (r >> 4) * 2 + (c >> 5), rr = r & 15, cc = c & 31, ob = rr * 64 + cc * 2; return st * 1024 + (ob ^ (((ob >> 9) & 1) << 5)); }
__host__ __device__ __forceinline__ void stage_rc(int b, int& R, int& C) { const int st = b / 1024, sb = b % 1024, swz = sb ^ (((sb >> 9) & 1) << 5); R = (st >> 1) * 16 + swz / 64; C = (st & 1) * 32 + (swz % 64) / 2; }
__host__ __device__ __forceinline__ int perm32(int rho) { const int n = rho >> 4, i = rho & 15; return 8 * (i >> 2) + 4 * n + (i & 3); }

struct Unit { int pm, pn, fin; const char* A; const char* B0; };
struct Gemm { int K, lda, ldb; };

template <class Epi, class Sched>
__device__ __forceinline__ void gemm_phase(LAS unsigned char* lds, const Gemm g, const Sched& S, const Epi& E) {
    const int tid = otid(), wid = __builtin_amdgcn_readfirstlane(tid >> 6), lane = tid & 63, wr = wid >> 2, wc = wid & 3, fr = lane & 15, fq = lane >> 4;
    int nt = g.K / BK; asm volatile("" : "+s"(nt));
    unsigned voffA[2], voffB[2];
#pragma unroll
    for (int i = 0; i < 2; ++i) { int R, C; stage_rc(tid * 16 + i * 8192, R, C); const int Rb = Epi::PERM ? ((R & ~31) + perm32(R & 31)) : R;
        voffA[i] = (unsigned)(R * g.lda + C) * 2u; voffB[i] = (unsigned)(Rb * g.ldb + C) * 2u; }
    if constexpr (Sched::FP8) { *(LAS u32x4*)(lds + PG8_VOOFF + (otid() << 4)) = (u32x4){voffA[0], voffA[1], voffB[0], voffB[1]}; }
    const size_t kstep = (size_t)(BK * 2);
    const size_t hstepA = Sched::GATHER ? (size_t)0 : (size_t)HALF * g.lda * 2, hstepB = (size_t)HALF * g.ldb * 2;
    unsigned cg0[2], cg1[2], ng0[2], ng1[2];
#define PG8_GOFFS(u, o0, o1) do { const int t_ = otid(); _Pragma("unroll") for (int i = 0; i < 2; ++i) { int R, C; stage_rc(t_ * 16 + i * 8192, R, C); \
        o0[i] = S.row_off(u, R) + (unsigned)C * 2u; o1[i] = S.row_off(u, HALF + R) + (unsigned)C * 2u; } } while (0)
    const unsigned ldsw = (unsigned)wid * 1024u;
    const int aoff = lds_byte(wr * 64 + fr, fq * 8), boff = lds_byte(wc * 32 + fr, fq * 8);
#define PG8_SA(b, h) (((b) * 2 + (h)) * HTB)
#define PG8_SB(b, h) ((4 + (b) * 2 + (h)) * HTB)
#define PG8_STAGE(bufoff, gbase, voff) do { unsigned vo_[2] = {(voff)[0], (voff)[1]}; \
        if constexpr (Sched::FP8) { const u32x4 pk_ = *(const LAS u32x4*)(lds + PG8_VOOFF + (otid() << 4)); const bool isb_ = (const void*)(voff) == (const void*)voffB; vo_[0] = isb_ ? pk_.z : pk_.x; vo_[1] = isb_ ? pk_.w : pk_.y; } \
        _Pragma("unroll") for (int _i = 0; _i < 2; ++_i) \
        __builtin_amdgcn_global_load_lds((const unsigned*)((const char*)(gbase) + vo_[_i]), (LAS unsigned*)(lds + (bufoff) + ldsw + _i * 8192), 16, 0, 0); } while (0)
#define PG8_LDA_M(dst, b, h, m0, nm) do { _Pragma("unroll") for (int m = 0; m < nm; ++m) { dst[m].lo = *(const LAS i32x4*)(lds + PG8_SA(b, h) + aoff + (m0 + m) * 2048); dst[m].hi = *(const LAS i32x4*)(lds + PG8_SA(b, h) + aoff + (m0 + m) * 2048 + 1024); } } while (0)
#define PG8_LDA(dst, b, h) do { if constexpr (Sched::FP8) PG8_LDA_M(dst, b, h, 0, 2); else PG8_LDA_M(dst, b, h, 0, 4); } while (0)
#define PG8_LDB(dst, b, h) do { _Pragma("unroll") for (int n = 0; n < 2; ++n) { dst[n].lo = *(const LAS i32x4*)(lds + PG8_SB(b, h) + boff + n * 2048); dst[n].hi = *(const LAS i32x4*)(lds + PG8_SB(b, h) + boff + n * 2048 + 1024); } } while (0)
#define PG8_H(x, k) __builtin_bit_cast(bf16x8, (k) ? (x).hi : (x).lo)
#define PG8_MMA8(ai, bj, At, Bt, m0) do { _Pragma("unroll") for (int m = 0; m < 2; ++m) _Pragma("unroll") for (int n = 0; n < 2; ++n) \
        acc[ai][bj][m0 + m][n] = __builtin_amdgcn_mfma_scale_f32_16x16x128_f8f6f4(Bt[n], At[m], acc[ai][bj][m0 + m][n], 0, 0, 0, 0x7f7f7f7f, 0, 0x7f7f7f7f); } while (0)
#define PG8_MMA2(ai, At, Bt0, Bt1, b, h) do { __builtin_amdgcn_s_setprio(1); \
        if constexpr (Sched::FP8) { PG8_MMA8(ai, 0, At, Bt0, 0); PG8_MMA8(ai, 1, At, Bt1, 0); __builtin_amdgcn_s_setprio(0); PG8_LDA_M(At, b, h, 2, 2); PG8_WAIT_L(0); PG8_SCHED; __builtin_amdgcn_s_setprio(1); \
            PG8_MMA8(ai, 0, At, Bt0, 2); PG8_MMA8(ai, 1, At, Bt1, 2); } \
        else { _Pragma("unroll") for (int bj = 0; bj < 2; ++bj) _Pragma("unroll") for (int m = 0; m < 4; ++m) _Pragma("unroll") for (int n = 0; n < 2; ++n) _Pragma("unroll") for (int k = 0; k < 2; ++k) \
        acc[ai][bj][m][n] = __builtin_amdgcn_mfma_f32_16x16x32_bf16(PG8_H(bj ? Bt1[n] : Bt0[n], k), PG8_H(At[m], k), acc[ai][bj][m][n], 0, 0, 0); } __builtin_amdgcn_s_setprio(0); } while (0)
#define PG8_WAIT_V(n) asm volatile("s_waitcnt vmcnt(" #n ")" ::: "memory")
#define PG8_WAIT_L(n) asm volatile("s_waitcnt lgkmcnt(" #n ")" ::: "memory")
#define PG8_BAR __builtin_amdgcn_s_barrier()
#define PG8_SCHED __builtin_amdgcn_sched_barrier(0)
    Unit cur, nxt; int ui = 0;
    if (!S.next(0, cur)) return;
    f32x4 acc[2][2][4][2];
#pragma unroll
    for (int a = 0; a < 2; ++a)
#pragma unroll
        for (int b = 0; b < 2; ++b)
#pragma unroll
            for (int m = 0; m < 4; ++m)
#pragma unroll
                for (int n = 0; n < 2; ++n) acc[a][b][m][n] = (f32x4){0.f, 0.f, 0.f, 0.f};
    i32x8 At[4], B0[2], B1[2];
    const char* cA = cur.A; const char* cBq = cur.B0;
    if constexpr (Sched::GATHER) { PG8_GOFFS(cur, cg0, cg1); } else {
#pragma unroll
        for (int i = 0; i < 2; ++i) { cg0[i] = voffA[i]; cg1[i] = voffA[i]; } }
    {
        const char* cB = cur.B0;
        PG8_STAGE(PG8_SB(0, 0), cB, voffB); PG8_STAGE(PG8_SB(0, 1), cB + hstepB, voffB); PG8_STAGE(PG8_SA(0, 0), cA, cg0); PG8_STAGE(PG8_SA(0, 1), cA + hstepA, cg1);
        if (wr == 1) PG8_BAR;
        PG8_WAIT_V(2); PG8_BAR;
        PG8_STAGE(PG8_SB(1, 0), cB + kstep, voffB); PG8_STAGE(PG8_SA(1, 0), cA + kstep, cg0); PG8_STAGE(PG8_SB(1, 1), cB + hstepB + kstep, voffB);
        PG8_WAIT_V(6); PG8_BAR;
    }
    for (;;) {
        const bool has_next = S.next(ui + 1, nxt);
        const char* nA = has_next ? nxt.A : cA; const char* nB = has_next ? nxt.B0 : cBq;
        if constexpr (Sched::GATHER) { if (has_next) { PG8_GOFFS(nxt, ng0, ng1); } else {
#pragma unroll
            for (int i = 0; i < 2; ++i) { ng0[i] = cg0[i]; ng1[i] = cg1[i]; } } }
        for (int t = 0; t < nt; t += 2) {
            const bool last = (t == nt - 2);
            const char* a1 = cA + (size_t)(t + 1) * kstep;
            const char* a2 = last ? nA : cA + (size_t)(t + 2) * kstep; const char* b2 = last ? nB : cBq + (size_t)(t + 2) * kstep;
            const char* a3 = a2 + kstep; const char* b3 = b2 + kstep;
            unsigned s0[2], s1[2];
#pragma unroll
            for (int i = 0; i < 2; ++i) { s0[i] = (Sched::GATHER && last) ? ng0[i] : cg0[i]; s1[i] = (Sched::GATHER && last) ? ng1[i] : cg1[i]; }
            PG8_LDB(B0, 0, 0); PG8_LDB(B1, 0, 1); PG8_SCHED; PG8_LDA(At, 0, 0); PG8_STAGE(PG8_SA(1, 1), a1 + hstepA, cg1);
            PG8_WAIT_V(8); PG8_WAIT_L(0); PG8_BAR; PG8_MMA2(0, At, B0, B1, 0, 0); PG8_BAR; PG8_SCHED;
            PG8_LDA(At, 0, 1); PG8_STAGE(PG8_SB(0, 0), b2, voffB); PG8_STAGE(PG8_SB(0, 1), b2 + hstepB, voffB); PG8_STAGE(PG8_SA(0, 0), a2, s0);
            PG8_WAIT_V(8); PG8_WAIT_L(0); PG8_BAR; PG8_MMA2(1, At, B0, B1, 0, 1); PG8_BAR; PG8_SCHED;
            PG8_LDB(B0, 1, 0); PG8_LDB(B1, 1, 1); PG8_SCHED; PG8_LDA(At, 1, 0); PG8_STAGE(PG8_SA(0, 1), a2 + hstepA, s1);
            PG8_WAIT_V(8); PG8_WAIT_L(0); PG8_BAR; PG8_MMA2(0, At, B0, B1, 1, 0); PG8_BAR; PG8_SCHED;
            PG8_LDA(At, 1, 1); PG8_STAGE(PG8_SB(1, 0), b3, voffB); PG8_STAGE(PG8_SB(1, 1), b3 + hstepB, voffB); PG8_STAGE(PG8_SA(1, 0), a3, s0);
            PG8_WAIT_V(8); PG8_WAIT_L(0); PG8_BAR; PG8_MMA2(1, At, B0, B1, 1, 1); PG8_BAR; PG8_SCHED;
        }
        if (wr == 0) PG8_BAR;
        if (cur.fin) { const int l2_ = otid() & 63; E(acc, cur, wr, wc, l2_ & 15, l2_ >> 4); }
        if (!has_next) break;
        if (cur.fin)
#pragma unroll
        for (int a = 0; a < 2; ++a)
#pragma unroll
            for (int b = 0; b < 2; ++b)
#pragma unroll
                for (int m = 0; m < 4; ++m)
#pragma unroll
                    for (int n = 0; n < 2; ++n) acc[a][b][m][n] = (f32x4){0.f, 0.f, 0.f, 0.f};
        cur = nxt; cA = nA; cBq = nB; ++ui;
        if constexpr (Sched::GATHER) {
#pragma unroll
            for (int i = 0; i < 2; ++i) { cg0[i] = ng0[i]; cg1[i] = ng1[i]; } }
        if (wr == 1) PG8_BAR;
    }
    PG8_WAIT_V(0);
    PG8_BAR;
#undef PG8_SA
#undef PG8_SB
#undef PG8_STAGE
#undef PG8_LDA
#undef PG8_LDB
#undef PG8_MMA2
#undef PG8_MMA8
#undef PG8_LDA_M
#undef PG8_H
#undef PG8_WAIT_V
#undef PG8_WAIT_L
#undef PG8_BAR
#undef PG8_SCHED
#undef PG8_GOFFS
}

struct StaticOrder {
    static constexpr bool GATHER = false; static constexpr bool FP8 = false;
    __device__ unsigned row_off(const Unit&, int) const { return 0u; }
    int nM, nN, nwg, G, c; const char* A; const char* Bt; size_t tA, tB;
    __device__ void init(const void* A_, const void* Bt_, int M, int N, int lda, int ldb, int G_, int c_) { nM = M / BM; nN = N / BM; nwg = nM * nN; G = G_; c = c_; A = (const char*)A_; Bt = (const char*)Bt_; tA = (size_t)BM * lda * 2; tB = (size_t)BM * ldb * 2; }
    __device__ bool next(int i, Unit& u) const {
        const long L = (long)i * G + c; if (L >= nwg) return false;
        int wgid = (int)L; { const int q = nwg / NXCD, r = nwg % NXCD, xcd = wgid % NXCD, off = wgid / NXCD; wgid = (xcd < r ? xcd * (q + 1) : r * (q + 1) + (xcd - r) * q) + off; }
        const int nig = WGM * nN, gid = wgid / nig, fm = gid * WGM, gsz = (nM - fm) < WGM ? (nM - fm) : WGM;
        u.pm = fm + ((wgid % nig) % gsz); u.pn = (wgid % nig) / gsz; u.A = A + (size_t)u.pm * tA; u.B0 = Bt + (size_t)u.pn * tB; u.fin = 1; return true;
    }
};

struct EpiBf16 {
    static constexpr bool PERM = true;
    bf16_t* O; int ldc; const float* oml;
    __device__ __forceinline__ void operator()(const f32x4 (&acc)[2][2][4][2], const Unit& u, int wr, int wc, int fr, int fq) const {
        const int row0 = u.pm * BM + wr * 64 + fr, col0 = u.pn * BM + wc * 32 + 8 * fq;
        const int mode = (u.pn == 2 || u.pn == 3 || u.pn >= 10) ? 1 : ((u.pn >= 4 && u.pn <= 7) ? 2 : 0);
#pragma unroll
        for (int ai = 0; ai < 2; ++ai)
#pragma unroll
            for (int m = 0; m < 4; ++m) { bf16_t* rowp = O + (size_t)(row0 + ai * HALF + m * 16) * ldc + col0;
#pragma unroll
                for (int bj = 0; bj < 2; ++bj) { f32x4 v0 = acc[ai][bj][m][0], v1 = acc[ai][bj][m][1];
                    if (mode == 1) {
#pragma unroll
                        for (int j = 0; j < 4; ++j) { v0[j] = v0[j] * __builtin_amdgcn_rcpf(1.f + __expf(-v0[j])); v1[j] = v1[j] * __builtin_amdgcn_rcpf(1.f + __expf(-v1[j])); } }
                    else if (mode == 2) { const float* om = oml + (col0 + bj * HALF - 1024); const f32x4 m0 = *(const f32x4*)om, m1 = *(const f32x4*)(om + 4);
#pragma unroll
                        for (int j = 0; j < 4; ++j) { v0[j] = m0[j] * __builtin_amdgcn_rcpf(1.f + __expf(v0[j])); v1[j] = m1[j] * __builtin_amdgcn_rcpf(1.f + __expf(v1[j])); } }
                    u32x4 w; w.x = cvt_pk_bf16(v0[0], v0[1]); w.y = cvt_pk_bf16(v0[2], v0[3]); w.z = cvt_pk_bf16(v1[0], v1[1]); w.w = cvt_pk_bf16(v1[2], v1[3]);
                    *(u32x4*)(rowp + bj * HALF) = w; } }
    }
};
struct EpiResid {
    static constexpr bool PERM = false;
    const float* base; float* out;
    __device__ __forceinline__ void operator()(const f32x4 (&acc)[2][2][4][2], const Unit& u, int wr, int wc, int fr, int fq) const {
        const int row0 = u.pm * BM + wr * 64 + fr, col0 = u.pn * BM + wc * 32 + 4 * fq;
#pragma unroll
        for (int ai = 0; ai < 2; ++ai)
#pragma unroll
            for (int m = 0; m < 4; ++m) { const size_t off = (size_t)(row0 + ai * HALF + m * 16) * DM + col0;
#pragma unroll
                for (int bj = 0; bj < 2; ++bj)
#pragma unroll
                    for (int n = 0; n < 2; ++n) { const f32x4 b = *(const f32x4*)(base + off + bj * HALF + n * 16); *(f32x4*)(out + off + bj * HALF + n * 16) = b + acc[ai][bj][m][n]; } }
    }
};
}

__device__ __forceinline__ void transpose_item(const float* W, int N, int k0, int n0, bf16_t* dst, int dst_ld, int drow0, const float* scale, float* scr, int lane) {
#pragma unroll
  for (int i = 0; i < 32; ++i) { const int kk = 2 * i + (lane >> 5); float v = W[(size_t)(k0 + kk) * N + n0 + (lane & 31)]; if (scale) v *= scale[k0 + kk]; scr[kk * 33 + (lane & 31)] = v; }
  LDS_WAIT();
  const int c = lane & 7;
#pragma unroll
  for (int j = 0; j < 4; ++j) { const int n = (lane >> 3) + 8 * j; const float* s = scr + (8 * c) * 33 + n;
    u32x4 o; o.x = cvt_pk_bf16(s[0 * 33], s[1 * 33]); o.y = cvt_pk_bf16(s[2 * 33], s[3 * 33]); o.z = cvt_pk_bf16(s[4 * 33], s[5 * 33]); o.w = cvt_pk_bf16(s[6 * 33], s[7 * 33]);
    *(u32x4*)(dst + (size_t)(drow0 + n) * dst_ld + k0 + 8 * c) = o; }
  LDS_WAIT();
}

__device__ __forceinline__ void transpose_item_fp8(const float* W, int N, int k0, int n0, unsigned char* dst, int dst_ld, int drow0, float sc, float* scr, int lane) {
#pragma unroll 8
  for (int i = 0; i < 32; ++i) { const int kk = 2 * i + (lane >> 5); scr[kk * 33 + (lane & 31)] = W[(size_t)(k0 + kk) * N + n0 + (lane & 31)] * sc; }
  LDS_WAIT();
  const int c = lane & 7;
#pragma unroll
  for (int j = 0; j < 4; ++j) { const int n = (lane >> 3) + 8 * j; const float* s = scr + (8 * c) * 33 + n;
    u32x2 o; o.x = pk4_fp8(s[0 * 33], s[1 * 33], s[2 * 33], s[3 * 33]); o.y = pk4_fp8(s[4 * 33], s[5 * 33], s[6 * 33], s[7 * 33]);
    *(u32x2*)(dst + (size_t)(drow0 + n) * dst_ld + k0 + 8 * c) = o; }
  LDS_WAIT();
}

__device__ __forceinline__ void phase_prep(const Params& p, char* lds) {
  const int tid = otid(), lane = tid & 63, wave = tid >> 6;
  const int gw = blockIdx.x * 8 + wave, NGW = gridDim.x * 8;
  unsigned char* ws = p.ws;
  float* scr = (float*)(lds + wave * 8704);
  constexpr int I_IN = 16 * 93, I_UQ = 4 * 24, I_UKV = 2 * 32, I_OUT = 16 * 32, I_G = 32 * 16 * 8, I_D = 32 * 4 * 32;
  constexpr int NITEMS = I_IN + I_UQ + I_UKV + I_OUT + 2 * I_G + I_D;
  for (int it = gw; it < NITEMS; it += NGW) {
    int r = it;
    if (r < I_IN) { const int kb = r / 93, nb = r % 93, n0 = nb * 32; transpose_item(p.w_in, N_IN, kb * 64, n0, (bf16_t*)(ws + WS_WIN), DM, n0 < 416 ? n0 : n0 + 96, nullptr, scr, lane); continue; } r -= I_IN;
    if (r < I_UQ) { const int kb = r / 24, nb = r % 24; transpose_item(p.w_uq, 768, kb * 64, nb * 32, (bf16_t*)(ws + WS_WUQ), QLORA, nb * 32, p.q_lat_norm, scr, lane); continue; } r -= I_UQ;
    if (r < I_UKV) { const int kb = r / 32, nb = r % 32; transpose_item(p.w_ukv, 1024, kb * 64, nb * 32, (bf16_t*)(ws + WS_WUKV), KVLORA, nb * 32, p.kv_lat_norm, scr, lane); continue; } r -= I_UKV;
    if (r < I_OUT) { const int kb = r / 32, nb = r % 32; transpose_item(p.w_out, DM, kb * 64, nb * 32, (bf16_t*)(ws + WS_WOUT), DM, nb * 32, nullptr, scr, lane); continue; } r -= I_OUT;
    if (r < 2 * I_G) { const int up = r / I_G; r %= I_G; const int e = r / 128, q = r % 128, kb = q / 8, nb = q % 8, n0 = nb * 32;
      transpose_item_fp8((up ? p.w_up : p.w_gate) + (size_t)e * DM * DEXP, DEXP, kb * 64, n0, (unsigned char*)(ws + WS_WGU) + (size_t)e * 512 * DM, DM, (n0 >> 7) * 256 + up * 128 + (n0 & 127), WGU_SCALE, scr, lane); continue; } r -= 2 * I_G;
    { const int e = r / 128, q = r % 128, kb = q / 32, nb = q % 32; transpose_item_fp8(p.w_down + (size_t)e * DEXP * DM, DM, kb * 64, nb * 32, (unsigned char*)(ws + WS_WD) + (size_t)e * DM * DEXP, DEXP, nb * 32, WD_SCALE, scr, lane); }
  }
  for (int i = blockIdx.x * 512 + tid; i < 96 * 1024 / 8; i += gridDim.x * 512) ((u32x4*)(ws + WS_WIN + (size_t)416 * DM * 2))[i] = (u32x4){0u, 0u, 0u, 0u};
  for (int i = blockIdx.x * 512 + tid; i < 1024; i += gridDim.x * 512) ((float*)(ws + WS_OML))[i] = 1.f - 1.f / (1.f + __expf(p.lb_logits[1024 + i] - p.lb_logits[i]));
  for (int i = blockIdx.x * 512 + tid; i < SEQ * 16; i += gridDim.x * 512) {
    const int pos = i >> 4, j = i & 15;
    const float inv = 1.0f / powf(10000.0f, (float)j / 16.0f);
    const float ang = (float)pos * inv;
    double rev = (double)ang * 0.15915494309189535; rev -= __builtin_floor(rev);
    const float fr = (float)rev;
    ((float*)(ws + WS_ROPE))[i] = __builtin_amdgcn_cosf(fr);
    ((float*)(ws + WS_ROPE))[SEQ * 16 + i] = __builtin_amdgcn_sinf(fr);
  }
  for (int i = blockIdx.x * 512 + tid; i < 64 * DM; i += gridDim.x * 512) { const int c = i >> 10, k = i & 1023;
    const float w = c < 32 ? p.w_router[k * 32 + c] : (c < 36 ? p.w_group[k * 4 + (c - 32)] : 0.f);
    const unsigned short wh = f2bf(w); const unsigned short wl = f2bf(w - bf2f(wh));
    ((bf16_t*)(ws + WS_WR))[i] = wh; ((bf16_t*)(ws + WS_WR))[64 * DM + i] = wl; }
  bf16_t* XN = (bf16_t*)(ws + WS_R1);
  f32x4 g[4];
#pragma unroll
  for (int j = 0; j < 4; ++j) g[j] = ((const f32x4*)p.norm_mix)[lane + 64 * j];
  for (int m0 = gw; m0 < T; m0 += 4 * NGW) {
    f32x4 v[4][4];
#pragma unroll
    for (int q = 0; q < 4; ++q) { const int m = m0 + q * NGW; const f32x4* xr = (const f32x4*)(p.x + (size_t)(m < T ? m : m0) * DM) + lane;
#pragma unroll
      for (int j = 0; j < 4; ++j) v[q][j] = xr[64 * j]; }
#pragma unroll
    for (int q = 0; q < 4; ++q) { const int m = m0 + q * NGW; if (m >= T) break;
      float s = 0.f;
#pragma unroll
      for (int j = 0; j < 4; ++j) s += (v[q][j].x * v[q][j].x + v[q][j].y * v[q][j].y) + (v[q][j].z * v[q][j].z + v[q][j].w * v[q][j].w);
      const float rs = rsqrtf(wave_sum(s) * (1.f / DM) + EPS);
      u32x2* o8 = (u32x2*)(XN + (size_t)m * DM) + lane;
#pragma unroll
      for (int j = 0; j < 4; ++j) { u32x2 w; w.x = cvt_pk_bf16(v[q][j].x * rs * g[j].x, v[q][j].y * rs * g[j].y); w.y = cvt_pk_bf16(v[q][j].z * rs * g[j].z, v[q][j].w * rs * g[j].w); o8[64 * j] = w; } }
  }
}

template <int OFF> __device__ __forceinline__ s16x4 tr_read_g(int vb) {
  s16x4 r; asm volatile("ds_read_b64_tr_b16 %0, %1 offset:%2" : "=&v"(r) : "v"(vb), "i"(OFF) : "memory"); return r;
}
template <int KS, int HF> __device__ __forceinline__ void pv_gen(f32x16& od, int vb, bf16x8 pa0, bf16x8 pa1, bf16x8 pa2, bf16x8 pa3) {
  const s16x4 l0 = tr_read_g<0>(vb), h0 = tr_read_g<HF>(vb), l1 = tr_read_g<KS>(vb), h1 = tr_read_g<KS + HF>(vb);
  const s16x4 l2 = tr_read_g<2 * KS>(vb), h2 = tr_read_g<2 * KS + HF>(vb), l3 = tr_read_g<3 * KS>(vb), h3 = tr_read_g<3 * KS + HF>(vb);
  asm volatile("s_waitcnt lgkmcnt(0)" ::: "memory"); SBAR();
#define PK(L, H) (bf16x8){L[0], L[1], L[2], L[3], H[0], H[1], H[2], H[3]}
  od = __builtin_amdgcn_mfma_f32_32x32x16_bf16(pa0, PK(l0, h0), od, 0, 0, 0);
  od = __builtin_amdgcn_mfma_f32_32x32x16_bf16(pa1, PK(l1, h1), od, 0, 0, 0);
  od = __builtin_amdgcn_mfma_f32_32x32x16_bf16(pa2, PK(l2, h2), od, 0, 0, 0);
  od = __builtin_amdgcn_mfma_f32_32x32x16_bf16(pa3, PK(l3, h3), od, 0, 0, 0);
#undef PK
}
__device__ __forceinline__ int v_rd_base_g(int lane) { return ((lane & 3) << 3) | (((lane >> 2) & 3) << 6) | (((lane >> 4) & 1) << 5) | (((lane >> 5) & 1) << 8); }

__device__ __forceinline__ void phase_mla_prep(const Params& p, char* lds) {
  constexpr int PWQ = 528, PWK = 272, O_W = 0, O_G = 53248;
  const int tid = otid(), lane = tid & 63, wave = __builtin_amdgcn_readfirstlane(tid >> 6), r32 = lane & 31, hi = lane >> 5;
#define MP_DMA16(gbase, voff, laddr) asm volatile("s_mov_b32 m0, %0\n\ts_nop 0\n\tglobal_load_lds_dwordx4 %1, %2" :: "s"(laddr), "v"(voff), "s"(gbase) : "memory", "m0")
  const unsigned W_dma = (unsigned)(size_t)((LAS char*)lds) + O_W + wave * 1024;
  unsigned char* ws = p.ws;
  const bf16_t* proj = (const bf16_t*)(ws + WS_R2);
  const bf16_t* WUQ = (const bf16_t*)(ws + WS_WUQ);
  const bf16_t* WUKV = (const bf16_t*)(ws + WS_WUKV);
  const float* RC = (const float*)(ws + WS_ROPE); const float* RS = RC + SEQ * 16;
  unsigned char* Q8 = (unsigned char*)(ws + WS_R3); unsigned char* K8 = Q8 + (size_t)T * NH * 128; unsigned char* V8T = K8 + (size_t)T * NH * 128;
  float* gq = (float*)(lds + O_G); float* gk = gq + 96;
  if (tid < 96) { gq[tid] = p.q_norm[tid]; gk[tid] = p.k_norm[tid]; }
  for (int tile = blockIdx.x; tile < T / 256; tile += gridDim.x) {
    const int tok = tile * 256 + wave * 32 + r32, b = tok / SEQ, s = tok % SEQ;
    const bf16_t* prow = proj + (size_t)tok * NP;
    {
      bf16x8 bq[16]; float ssq = 0.f;
#pragma unroll
      for (int ks = 0; ks < 16; ++ks) { bq[ks] = *(const bf16x8*)(prow + ks * 16 + hi * 8);
#pragma unroll
        for (int j = 0; j < 8; ++j) { const float v = bf2f((unsigned short)bq[ks][j]); ssq += v * v; } }
      const float rq = rsqrtf((ssq + __shfl_xor(ssq, 32)) * (1.f / QLORA) + EPS);
      unsigned vq[7];
#pragma unroll
      for (int i = 0; i < 7; ++i) { const int G = (i * 8 + wave) * 64 + lane, rw_ = G / 33, c_ = G % 33; vq[i] = (unsigned)(((rw_ < 96 ? rw_ : 95) * QLORA + (c_ < 32 ? c_ * 8 : 0)) * 2); }
#define MP_QDMA(head) do { const char* wb_ = (const char*)(WUQ + (size_t)(head) * 96 * QLORA); _Pragma("unroll") for (int i = 0; i < 7; ++i) if (i * 8 + wave < 50) MP_DMA16(wb_, vq[i], W_dma + i * 8192); } while (0)
      __syncthreads();
      MP_QDMA(0);
      for (int head_ = 0; head_ < NH; ++head_) {
        int head = head_; asm volatile("" : "+s"(head));
        asm volatile("s_waitcnt vmcnt(0)" ::: "memory");
        __syncthreads();
        f32x16 acc[3];
#pragma unroll
        for (int nb = 0; nb < 3; ++nb) acc[nb] = f32x16{};
#pragma unroll
        for (int ks = 0; ks < 16; ++ks) {
#pragma unroll
          for (int nb = 0; nb < 3; ++nb) { const bf16x8 a = *(const bf16x8*)(lds + O_W + (nb * 32 + r32) * PWQ + (ks * 16 + hi * 8) * 2);
            acc[nb] = __builtin_amdgcn_mfma_f32_32x32x16_bf16(a, bq[ks], acc[nb], 0, 0, 0); }
          if (ks & 1) SBAR(); }
        __syncthreads();
        if (head + 1 < NH) MP_QDMA(head + 1);
        float ss = 0.f;
#pragma unroll
        for (int nb = 0; nb < 3; ++nb)
#pragma unroll
          for (int r = 0; r < 16; ++r) { const float u = acc[nb][r] * rq; acc[nb][r] = u; ss += u * u; }
        ss += __shfl_xor(ss, 32);
        const float rn = rsqrtf(ss * (1.f / DQK) + EPS) * QS2;
#pragma unroll
        for (int nb = 0; nb < 3; ++nb)
#pragma unroll
          for (int r = 0; r < 16; ++r) acc[nb][r] *= rn * gq[nb * 32 + crow(r, hi)];
#pragma unroll
        for (int r = 0; r < 8; ++r) { const int i = crow(r, hi); const float c = RC[s * 16 + i], sn = RS[s * 16 + i];
          const float x1 = acc[2][r], x2 = acc[2][r + 8]; acc[2][r] = x1 * c - x2 * sn; acc[2][r + 8] = x2 * c + x1 * sn; }
        unsigned char* qrow = Q8 + ((size_t)(b * NH + head) * SEQ + s) * 128;
#pragma unroll
        for (int nb = 0; nb < 3; ++nb)
#pragma unroll
          for (int g = 0; g < 4; ++g) *(unsigned*)(qrow + nb * 32 + 8 * g + 4 * hi) = pk4_fp8(acc[nb][4 * g], acc[nb][4 * g + 1], acc[nb][4 * g + 2], acc[nb][4 * g + 3]);
        *(u32x4*)(qrow + 96 + 16 * hi) = (u32x4){0u, 0u, 0u, 0u};
      }
    }
    asm volatile("" ::: "memory");
    {
      bf16x8 bk[8]; float ssk = 0.f;
#pragma unroll
      for (int ks = 0; ks < 8; ++ks) { bk[ks] = *(const bf16x8*)(prow + C_KVL + ks * 16 + hi * 8);
#pragma unroll
        for (int j = 0; j < 8; ++j) { const float v = bf2f((unsigned short)bk[ks][j]); ssk += v * v; } }
      const float rkv = rsqrtf((ssk + __shfl_xor(ssk, 32)) * (1.f / KVLORA) + EPS);
      u32x2 krw[4]; float ssr = 0.f;
#pragma unroll
      for (int g = 0; g < 4; ++g) { krw[g] = *(const u32x2*)(prow + C_KR + 8 * g + 4 * hi);
        ssr += bflo(krw[g].x) * bflo(krw[g].x) + bfhi(krw[g].x) * bfhi(krw[g].x) + bflo(krw[g].y) * bflo(krw[g].y) + bfhi(krw[g].y) * bfhi(krw[g].y); }
      unsigned vk[5];
#pragma unroll
      for (int i = 0; i < 5; ++i) { const int G = (i * 8 + wave) * 64 + lane, rw_ = G / 17, c_ = G % 17; vk[i] = (unsigned)(((rw_ < 128 ? rw_ : 127) * KVLORA + (c_ < 16 ? c_ * 8 : 0)) * 2); }
#define MP_KDMA(head) do { const char* wb_ = (const char*)(WUKV + (size_t)(head) * 128 * KVLORA); _Pragma("unroll") for (int i = 0; i < 5; ++i) if (i * 8 + wave < 34) MP_DMA16(wb_, vk[i], W_dma + i * 8192); } while (0)
      __syncthreads();
      MP_KDMA(0);
      for (int head_ = 0; head_ < NH; ++head_) {
        int head = head_; asm volatile("" : "+s"(head));
        asm volatile("s_waitcnt vmcnt(0)" ::: "memory");
        __syncthreads();
        f32x16 acc[4];
#pragma unroll
        for (int nb = 0; nb < 4; ++nb) acc[nb] = f32x16{};
#pragma unroll
        for (int ks = 0; ks < 8; ++ks) {
#pragma unroll
          for (int nb = 0; nb < 4; ++nb) { const bf16x8 a = *(const bf16x8*)(lds + O_W + (nb * 32 + r32) * PWK + (ks * 16 + hi * 8) * 2);
            acc[nb] = __builtin_amdgcn_mfma_f32_32x32x16_bf16(a, bk[ks], acc[nb], 0, 0, 0); }
          if (ks & 1) SBAR(); }
        __syncthreads();
        if (head + 1 < NH) MP_KDMA(head + 1);
        float ss = ssr;
#pragma unroll
        for (int nb = 0; nb < 4; ++nb)
#pragma unroll
          for (int r = 0; r < 16; ++r) { const float u = acc[nb][r] * rkv; acc[nb][r] = u; if (nb < 2) ss += u * u; }
        ss += __shfl_xor(ss, 32);
        const float rn = rsqrtf(ss * (1.f / DQK) + EPS) * QS2;
#pragma unroll
        for (int nb = 0; nb < 2; ++nb)
#pragma unroll
          for (int r = 0; r < 16; ++r) acc[nb][r] *= rn * gk[nb * 32 + crow(r, hi)];
        float kr[16];
#pragma unroll
        for (int g = 0; g < 4; ++g) { kr[4 * g] = bflo(krw[g].x); kr[4 * g + 1] = bfhi(krw[g].x); kr[4 * g + 2] = bflo(krw[g].y); kr[4 * g + 3] = bfhi(krw[g].y); }
#pragma unroll
        for (int r = 0; r < 16; ++r) kr[r] *= rn * gk[64 + crow(r, hi)];
#pragma unroll
        for (int r = 0; r < 8; ++r) { const int i = crow(r, hi); const float c = RC[s * 16 + i], sn = RS[s * 16 + i];
          const float x1 = kr[r], x2 = kr[r + 8]; kr[r] = x1 * c - x2 * sn; kr[r + 8] = x2 * c + x1 * sn; }
        unsigned char* krow = K8 + ((size_t)(b * NH + head) * SEQ + s) * 128;
        unsigned char* vcol = V8T + (size_t)(b * NH + head) * DVH * SEQ + ((s & ~63) | ((s & 4) << 3) | ((s & 32) >> 1) | ((s & 16) >> 1) | ((s & 8) >> 1) | (s & 3));
#pragma unroll
        for (int nb = 0; nb < 2; ++nb)
#pragma unroll
          for (int g = 0; g < 4; ++g) *(unsigned*)(krow + nb * 32 + 8 * g + 4 * hi) = pk4_fp8(acc[nb][4 * g], acc[nb][4 * g + 1], acc[nb][4 * g + 2], acc[nb][4 * g + 3]);
#pragma unroll
        for (int g = 0; g < 4; ++g) *(unsigned*)(krow + 64 + 8 * g + 4 * hi) = pk4_fp8(kr[4 * g], kr[4 * g + 1], kr[4 * g + 2], kr[4 * g + 3]);
        *(u32x4*)(krow + 96 + 16 * hi) = (u32x4){0u, 0u, 0u, 0u};
#pragma unroll
        for (int nb = 2; nb < 4; ++nb)
#pragma unroll
          for (int r = 0; r < 16; r += 2) { const unsigned w = (unsigned)__builtin_amdgcn_cvt_pk_fp8_f32(__builtin_amdgcn_fmed3f(acc[nb][r], -448.f, 448.f), __builtin_amdgcn_fmed3f(acc[nb][r + 1], -448.f, 448.f), 0, false);
            vcol[(size_t)((nb - 2) * 32 + crow(r, hi)) * SEQ] = (unsigned char)(w & 0xffu); vcol[(size_t)((nb - 2) * 32 + crow(r + 1, hi)) * SEQ] = (unsigned char)((w >> 8) & 0xffu); }
      }
    }
    __syncthreads();
  }
}

namespace hg {
constexpr int PQ = 272, PS = 144;
constexpr int O_QD = 0, O_KD = O_QD + 64 * PQ, O_KTR = O_KD + 64 * PQ, O_V = O_KTR + 128 * PS, O_EV = O_V + 4096, BUF = O_EV + 1024;
constexpr int O_ST = 2 * BUF, O_OI = O_ST + 32 * PQ, O_TOT = O_OI + 2 * 32 * 144, O_FLAG = O_TOT + 4096, O_END = O_FLAG + 64;
__device__ __forceinline__ int v_st1(int k, int c) { const int kk = (k & ~0xC) | ((k & 4) << 1) | ((k & 8) >> 1); return (kk >> 3) * 512 + ((kk & 7) * 32 + c) * 2; }
}
__device__ __forceinline__ void phase_hgrn_fused(const Params& p, char* lds) {
  using namespace hg;
  const int tid = otid(), lane = tid & 63, dp = tid & 63, te = tid >> 6, r32 = lane & 31, hi = lane >> 5;
  const int wave = __builtin_amdgcn_readfirstlane(tid >> 6);
  unsigned char* ws = p.ws;
  const bf16_t* proj = (const bf16_t*)(ws + WS_R2);
  bf16_t* OFB = (bf16_t*)(ws + WS_R1);
  float* tot = (float*)(lds + O_TOT);
  unsigned* flag = (unsigned*)(lds + O_FLAG);
#define HGF_PK4(P, BASE, OUT) do { unsigned a0_ = cvt_pk_bf16(P[BASE + 0], P[BASE + 1]), a1_ = cvt_pk_bf16(P[BASE + 2], P[BASE + 3]);   \
    unsigned b0_ = cvt_pk_bf16(P[BASE + 4], P[BASE + 5]), b1_ = cvt_pk_bf16(P[BASE + 6], P[BASE + 7]);                              \
    auto r0_ = __builtin_amdgcn_permlane32_swap(a0_, b0_, false, false); auto r1_ = __builtin_amdgcn_permlane32_swap(a1_, b1_, false, false); \
    u32x4 w_ = {r0_[0], r1_[0], r0_[1], r1_[1]}; OUT = *reinterpret_cast<bf16x8*>(&w_); } while (0)
#define HGF_PK(L, H) (bf16x8){L[0], L[1], L[2], L[3], H[0], H[1], H[2], H[3]}
  for (int unit = blockIdx.x; unit < 2 * BATCH * HGH * 4; unit += gridDim.x) {
    const int sl = (unit >> 3) & 3, g8 = (unit & 7) | ((unit >> 5) << 3);
    const int h = g8 & 3, b = (g8 >> 2) & 7, dir = g8 >> 5;
    const int d0 = 2 * dp;
    const bf16_t* pbase = proj + (size_t)b * SEQ * NP + h * 128;
    const int cfz = dir ? C_FB : C_FF;
    f32x16 S = f32x16{};
    struct RawRegs { unsigned rq[8], rz[8]; bf16x8 rv; };
    RawRegs RA, RB;
#define HGF_LOAD(R, c) do { _Pragma("unroll") for (int i = 0; i < 8; ++i) { const int tt_ = (c) * 64 + 8 * te + i; const int tn_ = dir ? (SEQ - 1 - tt_) : tt_; \
      const bf16_t* pr_ = pbase + (size_t)tn_ * NP + d0; R.rq[i] = *(const unsigned*)(pr_ + C_HQ); R.rz[i] = *(const unsigned*)(pr_ + cfz); } \
    if (tid < 256) { const int tt_ = (c) * 64 + (tid >> 2); const int tn_ = dir ? (SEQ - 1 - tt_) : tt_; R.rv = *(const bf16x8*)(pbase + (size_t)tn_ * NP + C_HI + sl * 32 + (tid & 3) * 8); } } while (0)
    HGF_LOAD(RA, 0); HGF_LOAD(RB, 1);
    if (tid < 3) flag[tid] = 0u;
      {
      if (0 < NCHUNK) {
        float t0_ = 1.f, t1_ = 1.f;
#pragma unroll
        for (int i = 0; i < 8; ++i) { t0_ *= 1.f - bflo(RA.rz[i]); t1_ *= 1.f - bfhi(RA.rz[i]); }
        tot[te * 128 + d0] = t0_; tot[te * 128 + d0 + 1] = t1_;
      }
      __syncthreads();
      if (0 < NCHUNK) {
        char* img = lds + 0 * BUF;
        float qf[8][2], kk[8][2], pp[8][2], sp[8][2];
#pragma unroll
        for (int i = 0; i < 8; ++i)
#pragma unroll
          for (int e = 0; e < 2; ++e) { qf[i][e] = e ? bfhi(RA.rq[i]) : bflo(RA.rq[i]); kk[i][e] = e ? bfhi(RA.rz[i]) : bflo(RA.rz[i]); const float f = 1.f - kk[i][e]; pp[i][e] = i ? pp[i - 1][e] * f : f; }
#pragma unroll
        for (int e = 0; e < 2; ++e) { sp[7][e] = 1.f;
#pragma unroll
          for (int i = 6; i >= 0; --i) sp[i][e] = sp[i + 1][e] * (1.f - kk[i + 1][e]); }
        const bf16x8 vcur = RA.rv;
        float off[2], pref[2], ptot[2];
#pragma unroll
        for (int e = 0; e < 2; ++e) { float o_ = 1.f, r_ = 1.f, t_ = 1.f;
#pragma unroll
          for (int j = 0; j < 8; ++j) { const float a = tot[j * 128 + d0 + e]; t_ *= a; if (j < te) o_ *= a; if (j < 4) r_ *= a; }
          off[e] = o_; pref[e] = r_; ptot[e] = t_; }
        const float ipr0 = __builtin_amdgcn_rcpf(pref[0]), ipr1 = __builtin_amdgcn_rcpf(pref[1]);
        const float qs0 = off[0] * ipr0, qs1 = off[1] * ipr1;
        const float ks0 = pref[0] * __builtin_amdgcn_rcpf(off[0] * pp[7][0]), ks1 = pref[1] * __builtin_amdgcn_rcpf(off[1] * pp[7][1]);
        unsigned wks[8];
#pragma unroll
        for (int i = 0; i < 8; ++i) { const int tl = 8 * te + i;
          const unsigned wq = cvt_pk_bf16(qf[i][0] * pp[i][0] * qs0, qf[i][1] * pp[i][1] * qs1);
          const unsigned wk = cvt_pk_bf16(kk[i][0] * sp[i][0] * ks0, kk[i][1] * sp[i][1] * ks1);
          *(unsigned*)(img + O_QD + tl * PQ + d0 * 2) = wq; *(unsigned*)(img + O_KD + tl * PQ + d0 * 2) = wk; wks[i] = wk; }
#pragma unroll
        for (int e = 0; e < 2; ++e) { u32x4 w_;
#pragma unroll
          for (int j = 0; j < 4; ++j) { const unsigned a_ = e ? (wks[2 * j] >> 16) : (wks[2 * j] & 0xffffu), b_ = e ? (wks[2 * j + 1] >> 16) : (wks[2 * j + 1] & 0xffffu); w_[j] = a_ | (b_ << 16); }
          *(u32x4*)(img + O_KTR + (d0 + e) * PS + te * 16) = w_; }
        float* evw = (float*)(img + O_EV);
        if (te == 0) { evw[d0] = pref[0]; evw[d0 + 1] = pref[1]; evw[128 + d0] = ptot[0] * ipr0; evw[128 + d0 + 1] = ptot[1] * ipr1; }
        if (tid < 256) *(bf16x8*)(img + O_V + v_st1(tid >> 2, (tid & 3) * 8)) = vcur;
        if (0 + 2 < NCHUNK) HGF_LOAD(RA, 0 + 2);
      }
      if (-1 >= 0) {
        const int c = -1; const char* img = lds + 1 * BUF; const float* evl = (const float*)(img + O_EV);
        const int vbV = (int)(uintptr_t)(img + O_V) + v_rd_base_g(lane);
        if (wave >= 4) {
          const int db = wave - 4;
          f32x16 Sp;
#pragma unroll
          for (int r = 0; r < 16; ++r) Sp[r] = S[r] * evl[db * 32 + crow(r, hi)];
#pragma unroll
          for (int g = 0; g < 4; ++g) { u32x2 w; w.x = cvt_pk_bf16(Sp[4 * g], Sp[4 * g + 1]); w.y = cvt_pk_bf16(Sp[4 * g + 2], Sp[4 * g + 3]);
            *(u32x2*)(lds + O_ST + r32 * PQ + (db * 32 + 8 * g + 4 * hi) * 2) = w; }
          asm volatile("s_waitcnt lgkmcnt(0)" ::: "memory");
          if (lane == 0) __hip_atomic_fetch_add(flag, 1u, __ATOMIC_RELEASE, __HIP_MEMORY_SCOPE_WORKGROUP);
          bf16x8 ka[4];
#pragma unroll
          for (int ks = 0; ks < 4; ++ks) ka[ks] = *(const bf16x8*)(img + O_KTR + (db * 32 + r32) * PS + (ks * 16 + hi * 8) * 2);
          const s16x4 l0 = tr_read_g<0>(vbV), h0 = tr_read_g<512>(vbV), l1 = tr_read_g<1024>(vbV), h1 = tr_read_g<1536>(vbV);
          const s16x4 l2 = tr_read_g<2048>(vbV), h2 = tr_read_g<2560>(vbV), l3 = tr_read_g<3072>(vbV), h3 = tr_read_g<3584>(vbV);
          asm volatile("s_waitcnt lgkmcnt(0)" ::: "memory"); SBAR();
          Sp = __builtin_amdgcn_mfma_f32_32x32x16_bf16(ka[0], HGF_PK(l0, h0), Sp, 0, 0, 0);
          Sp = __builtin_amdgcn_mfma_f32_32x32x16_bf16(ka[1], HGF_PK(l1, h1), Sp, 0, 0, 0);
          Sp = __builtin_amdgcn_mfma_f32_32x32x16_bf16(ka[2], HGF_PK(l2, h2), Sp, 0, 0, 0);
          Sp = __builtin_amdgcn_mfma_f32_32x32x16_bf16(ka[3], HGF_PK(l3, h3), Sp, 0, 0, 0);
#pragma unroll
          for (int r = 0; r < 16; ++r) S[r] = Sp[r] * evl[128 + db * 32 + crow(r, hi)];
        } else if (wave < 2) {
          const int tb = wave;
          f32x16 o = f32x16{};
          f32x16 p0 = f32x16{}, p1 = f32x16{};
#pragma unroll
          for (int ks = 0; ks < 8; ++ks) { const int cb = (ks * 16 + hi * 8) * 2;
            const bf16x8 qv = *(const bf16x8*)(img + O_QD + (tb * 32 + r32) * PQ + cb);
            const bf16x8 a0 = *(const bf16x8*)(img + O_KD + r32 * PQ + cb);
            p0 = __builtin_amdgcn_mfma_f32_32x32x16_bf16(a0, qv, p0, 0, 0, 0);
            if (tb) { const bf16x8 a1 = *(const bf16x8*)(img + O_KD + (32 + r32) * PQ + cb); p1 = __builtin_amdgcn_mfma_f32_32x32x16_bf16(a1, qv, p1, 0, 0, 0); } }
          const int tq = tb * 32 + r32;
#pragma unroll
          for (int r = 0; r < 16; ++r) { const int s0 = crow(r, hi); p0[r] = (s0 <= tq) ? p0[r] : 0.f; p1[r] = (32 + s0 <= tq) ? p1[r] : 0.f; }
          bf16x8 pa0, pa1, pa2, pa3;
          HGF_PK4(p0, 0, pa0); HGF_PK4(p0, 8, pa1); HGF_PK4(p1, 0, pa2); HGF_PK4(p1, 8, pa3);
          pv_gen<1024, 512>(o, vbV, pa0, pa1, pa2, pa3);
          float* oi = (float*)(lds + O_OI) + tb * (32 * 36);
#pragma unroll
          for (int r = 0; r < 16; ++r) oi[crow(r, hi) * 36 + r32] = o[r];
          asm volatile("s_waitcnt lgkmcnt(0)" ::: "memory");
          if (lane == 0) __hip_atomic_fetch_add(flag + 1 + tb, 1u, __ATOMIC_RELEASE, __HIP_MEMORY_SCOPE_WORKGROUP);
        } else {
          const int tb = wave - 2;
          { const unsigned want = 4u * (unsigned)(c + 1); while (__hip_atomic_load(flag, __ATOMIC_ACQUIRE, __HIP_MEMORY_SCOPE_WORKGROUP) < want) __builtin_amdgcn_s_sleep(1); }
          f32x16 o = f32x16{};
#pragma unroll
          for (int ks = 0; ks < 8; ++ks) { const bf16x8 a = *(const bf16x8*)(lds + O_ST + r32 * PQ + (ks * 16 + hi * 8) * 2);
            const bf16x8 bb = *(const bf16x8*)(img + O_QD + (tb * 32 + r32) * PQ + (ks * 16 + hi * 8) * 2);
            o = __builtin_amdgcn_mfma_f32_32x32x16_bf16(a, bb, o, 0, 0, 0); }
          { const unsigned want = (unsigned)(c + 1); while (__hip_atomic_load(flag + 1 + tb, __ATOMIC_ACQUIRE, __HIP_MEMORY_SCOPE_WORKGROUP) < want) __builtin_amdgcn_s_sleep(1); }
          const float* oi = (const float*)(lds + O_OI) + tb * (32 * 36) + r32 * 36;
          const int tt = c * 64 + tb * 32 + r32; const int tn = dir ? (SEQ - 1 - tt) : tt;
          bf16_t* orow = OFB + ((size_t)dir * T + (size_t)b * SEQ + tn) * 512 + h * 128 + sl * 32;
#pragma unroll
          for (int g = 0; g < 4; ++g) { const f32x4 iv = *(const f32x4*)(oi + 8 * g + 4 * hi);
            u32x2 w; w.x = cvt_pk_bf16(o[4 * g] + iv.x, o[4 * g + 1] + iv.y); w.y = cvt_pk_bf16(o[4 * g + 2] + iv.z, o[4 * g + 3] + iv.w);
            *(u32x2*)(orow + 8 * g + 4 * hi) = w; }
        }
      }
      __syncthreads();
      }
    for (int c2 = 0; c2 < NCHUNK; c2 += 2) {
      {
      if ((c2 + 1) < NCHUNK) {
        float t0_ = 1.f, t1_ = 1.f;
#pragma unroll
        for (int i = 0; i < 8; ++i) { t0_ *= 1.f - bflo(RB.rz[i]); t1_ *= 1.f - bfhi(RB.rz[i]); }
        tot[te * 128 + d0] = t0_; tot[te * 128 + d0 + 1] = t1_;
      }
      __syncthreads();
      if ((c2 + 1) < NCHUNK) {
        char* img = lds + 1 * BUF;
        float qf[8][2], kk[8][2], pp[8][2], sp[8][2];
#pragma unroll
        for (int i = 0; i < 8; ++i)
#pragma unroll
          for (int e = 0; e < 2; ++e) { qf[i][e] = e ? bfhi(RB.rq[i]) : bflo(RB.rq[i]); kk[i][e] = e ? bfhi(RB.rz[i]) : bflo(RB.rz[i]); const float f = 1.f - kk[i][e]; pp[i][e] = i ? pp[i - 1][e] * f : f; }
#pragma unroll
        for (int e = 0; e < 2; ++e) { sp[7][e] = 1.f;
#pragma unroll
          for (int i = 6; i >= 0; --i) sp[i][e] = sp[i + 1][e] * (1.f - kk[i + 1][e]); }
        const bf16x8 vcur = RB.rv;
        float off[2], pref[2], ptot[2];
#pragma unroll
        for (int e = 0; e < 2; ++e) { float o_ = 1.f, r_ = 1.f, t_ = 1.f;
#pragma unroll
          for (int j = 0; j < 8; ++j) { const float a = tot[j * 128 + d0 + e]; t_ *= a; if (j < te) o_ *= a; if (j < 4) r_ *= a; }
          off[e] = o_; pref[e] = r_; ptot[e] = t_; }
        const float ipr0 = __builtin_amdgcn_rcpf(pref[0]), ipr1 = __builtin_amdgcn_rcpf(pref[1]);
        const float qs0 = off[0] * ipr0, qs1 = off[1] * ipr1;
        const float ks0 = pref[0] * __builtin_amdgcn_rcpf(off[0] * pp[7][0]), ks1 = pref[1] * __builtin_amdgcn_rcpf(off[1] * pp[7][1]);
        unsigned wks[8];
#pragma unroll
        for (int i = 0; i < 8; ++i) { const int tl = 8 * te + i;
          const unsigned wq = cvt_pk_bf16(qf[i][0] * pp[i][0] * qs0, qf[i][1] * pp[i][1] * qs1);
          const unsigned wk = cvt_pk_bf16(kk[i][0] * sp[i][0] * ks0, kk[i][1] * sp[i][1] * ks1);
          *(unsigned*)(img + O_QD + tl * PQ + d0 * 2) = wq; *(unsigned*)(img + O_KD + tl * PQ + d0 * 2) = wk; wks[i] = wk; }
#pragma unroll
        for (int e = 0; e < 2; ++e) { u32x4 w_;
#pragma unroll
          for (int j = 0; j < 4; ++j) { const unsigned a_ = e ? (wks[2 * j] >> 16) : (wks[2 * j] & 0xffffu), b_ = e ? (wks[2 * j + 1] >> 16) : (wks[2 * j + 1] & 0xffffu); w_[j] = a_ | (b_ << 16); }
          *(u32x4*)(img + O_KTR + (d0 + e) * PS + te * 16) = w_; }
        float* evw = (float*)(img + O_EV);
        if (te == 0) { evw[d0] = pref[0]; evw[d0 + 1] = pref[1]; evw[128 + d0] = ptot[0] * ipr0; evw[128 + d0 + 1] = ptot[1] * ipr1; }
        if (tid < 256) *(bf16x8*)(img + O_V + v_st1(tid >> 2, (tid & 3) * 8)) = vcur;
        if ((c2 + 1) + 2 < NCHUNK) HGF_LOAD(RB, (c2 + 1) + 2);
      }
      if (c2 >= 0) {
        const int c = c2; const char* img = lds + 0 * BUF; const float* evl = (const float*)(img + O_EV);
        const int vbV = (int)(uintptr_t)(img + O_V) + v_rd_base_g(lane);
        if (wave >= 4) {
          const int db = wave - 4;
          f32x16 Sp;
#pragma unroll
          for (int r = 0; r < 16; ++r) Sp[r] = S[r] * evl[db * 32 + crow(r, hi)];
#pragma unroll
          for (int g = 0; g < 4; ++g) { u32x2 w; w.x = cvt_pk_bf16(Sp[4 * g], Sp[4 * g + 1]); w.y = cvt_pk_bf16(Sp[4 * g + 2], Sp[4 * g + 3]);
            *(u32x2*)(lds + O_ST + r32 * PQ + (db * 32 + 8 * g + 4 * hi) * 2) = w; }
          asm volatile("s_waitcnt lgkmcnt(0)" ::: "memory");
          if (lane == 0) __hip_atomic_fetch_add(flag, 1u, __ATOMIC_RELEASE, __HIP_MEMORY_SCOPE_WORKGROUP);
          bf16x8 ka[4];
#pragma unroll
          for (int ks = 0; ks < 4; ++ks) ka[ks] = *(const bf16x8*)(img + O_KTR + (db * 32 + r32) * PS + (ks * 16 + hi * 8) * 2);
          const s16x4 l0 = tr_read_g<0>(vbV), h0 = tr_read_g<512>(vbV), l1 = tr_read_g<1024>(vbV), h1 = tr_read_g<1536>(vbV);
          const s16x4 l2 = tr_read_g<2048>(vbV), h2 = tr_read_g<2560>(vbV), l3 = tr_read_g<3072>(vbV), h3 = tr_read_g<3584>(vbV);
          asm volatile("s_waitcnt lgkmcnt(0)" ::: "memory"); SBAR();
          Sp = __builtin_amdgcn_mfma_f32_32x32x16_bf16(ka[0], HGF_PK(l0, h0), Sp, 0, 0, 0);
          Sp = __builtin_amdgcn_mfma_f32_32x32x16_bf16(ka[1], HGF_PK(l1, h1), Sp, 0, 0, 0);
          Sp = __builtin_amdgcn_mfma_f32_32x32x16_bf16(ka[2], HGF_PK(l2, h2), Sp, 0, 0, 0);
          Sp = __builtin_amdgcn_mfma_f32_32x32x16_bf16(ka[3], HGF_PK(l3, h3), Sp, 0, 0, 0);
#pragma unroll
          for (int r = 0; r < 16; ++r) S[r] = Sp[r] * evl[128 + db * 32 + crow(r, hi)];
        } else if (wave < 2) {
          const int tb = wave;
          f32x16 o = f32x16{};
          f32x16 p0 = f32x16{}, p1 = f32x16{};
#pragma unroll
          for (int ks = 0; ks < 8; ++ks) { const int cb = (ks * 16 + hi * 8) * 2;
            const bf16x8 qv = *(const bf16x8*)(img + O_QD + (tb * 32 + r32) * PQ + cb);
            const bf16x8 a0 = *(const bf16x8*)(img + O_KD + r32 * PQ + cb);
            p0 = __builtin_amdgcn_mfma_f32_32x32x16_bf16(a0, qv, p0, 0, 0, 0);
            if (tb) { const bf16x8 a1 = *(const bf16x8*)(img + O_KD + (32 + r32) * PQ + cb); p1 = __builtin_amdgcn_mfma_f32_32x32x16_bf16(a1, qv, p1, 0, 0, 0); } }
          const int tq = tb * 32 + r32;
#pragma unroll
          for (int r = 0; r < 16; ++r) { const int s0 = crow(r, hi); p0[r] = (s0 <= tq) ? p0[r] : 0.f; p1[r] = (32 + s0 <= tq) ? p1[r] : 0.f; }
          bf16x8 pa0, pa1, pa2, pa3;
          HGF_PK4(p0, 0, pa0); HGF_PK4(p0, 8, pa1); HGF_PK4(p1, 0, pa2); HGF_PK4(p1, 8, pa3);
          pv_gen<1024, 512>(o, vbV, pa0, pa1, pa2, pa3);
          float* oi = (float*)(lds + O_OI) + tb * (32 * 36);
#pragma unroll
          for (int r = 0; r < 16; ++r) oi[crow(r, hi) * 36 + r32] = o[r];
          asm volatile("s_waitcnt lgkmcnt(0)" ::: "memory");
          if (lane == 0) __hip_atomic_fetch_add(flag + 1 + tb, 1u, __ATOMIC_RELEASE, __HIP_MEMORY_SCOPE_WORKGROUP);
        } else {
          const int tb = wave - 2;
          { const unsigned want = 4u * (unsigned)(c + 1); while (__hip_atomic_load(flag, __ATOMIC_ACQUIRE, __HIP_MEMORY_SCOPE_WORKGROUP) < want) __builtin_amdgcn_s_sleep(1); }
          f32x16 o = f32x16{};
#pragma unroll
          for (int ks = 0; ks < 8; ++ks) { const bf16x8 a = *(const bf16x8*)(lds + O_ST + r32 * PQ + (ks * 16 + hi * 8) * 2);
            const bf16x8 bb = *(const bf16x8*)(img + O_QD + (tb * 32 + r32) * PQ + (ks * 16 + hi * 8) * 2);
            o = __builtin_amdgcn_mfma_f32_32x32x16_bf16(a, bb, o, 0, 0, 0); }
          { const unsigned want = (unsigned)(c + 1); while (__hip_atomic_load(flag + 1 + tb, __ATOMIC_ACQUIRE, __HIP_MEMORY_SCOPE_WORKGROUP) < want) __builtin_amdgcn_s_sleep(1); }
          const float* oi = (const float*)(lds + O_OI) + tb * (32 * 36) + r32 * 36;
          const int tt = c * 64 + tb * 32 + r32; const int tn = dir ? (SEQ - 1 - tt) : tt;
          bf16_t* orow = OFB + ((size_t)dir * T + (size_t)b * SEQ + tn) * 512 + h * 128 + sl * 32;
#pragma unroll
          for (int g = 0; g < 4; ++g) { const f32x4 iv = *(const f32x4*)(oi + 8 * g + 4 * hi);
            u32x2 w; w.x = cvt_pk_bf16(o[4 * g] + iv.x, o[4 * g + 1] + iv.y); w.y = cvt_pk_bf16(o[4 * g + 2] + iv.z, o[4 * g + 3] + iv.w);
            *(u32x2*)(orow + 8 * g + 4 * hi) = w; }
        }
      }
      __syncthreads();
      }
      {
      if ((c2 + 2) < NCHUNK) {
        float t0_ = 1.f, t1_ = 1.f;
#pragma unroll
        for (int i = 0; i < 8; ++i) { t0_ *= 1.f - bflo(RA.rz[i]); t1_ *= 1.f - bfhi(RA.rz[i]); }
        tot[te * 128 + d0] = t0_; tot[te * 128 + d0 + 1] = t1_;
      }
      __syncthreads();
      if ((c2 + 2) < NCHUNK) {
        char* img = lds + 0 * BUF;
        float qf[8][2], kk[8][2], pp[8][2], sp[8][2];
#pragma unroll
        for (int i = 0; i < 8; ++i)
#pragma unroll
          for (int e = 0; e < 2; ++e) { qf[i][e] = e ? bfhi(RA.rq[i]) : bflo(RA.rq[i]); kk[i][e] = e ? bfhi(RA.rz[i]) : bflo(RA.rz[i]); const float f = 1.f - kk[i][e]; pp[i][e] = i ? pp[i - 1][e] * f : f; }
#pragma unroll
        for (int e = 0; e < 2; ++e) { sp[7][e] = 1.f;
#pragma unroll
          for (int i = 6; i >= 0; --i) sp[i][e] = sp[i + 1][e] * (1.f - kk[i + 1][e]); }
        const bf16x8 vcur = RA.rv;
        float off[2], pref[2], ptot[2];
#pragma unroll
        for (int e = 0; e < 2; ++e) { float o_ = 1.f, r_ = 1.f, t_ = 1.f;
#pragma unroll
          for (int j = 0; j < 8; ++j) { const float a = tot[j * 128 + d0 + e]; t_ *= a; if (j < te) o_ *= a; if (j < 4) r_ *= a; }
          off[e] = o_; pref[e] = r_; ptot[e] = t_; }
        const float ipr0 = __builtin_amdgcn_rcpf(pref[0]), ipr1 = __builtin_amdgcn_rcpf(pref[1]);
        const float qs0 = off[0] * ipr0, qs1 = off[1] * ipr1;
        const float ks0 = pref[0] * __builtin_amdgcn_rcpf(off[0] * pp[7][0]), ks1 = pref[1] * __builtin_amdgcn_rcpf(off[1] * pp[7][1]);
        unsigned wks[8];
#pragma unroll
        for (int i = 0; i < 8; ++i) { const int tl = 8 * te + i;
          const unsigned wq = cvt_pk_bf16(qf[i][0] * pp[i][0] * qs0, qf[i][1] * pp[i][1] * qs1);
          const unsigned wk = cvt_pk_bf16(kk[i][0] * sp[i][0] * ks0, kk[i][1] * sp[i][1] * ks1);
          *(unsigned*)(img + O_QD + tl * PQ + d0 * 2) = wq; *(unsigned*)(img + O_KD + tl * PQ + d0 * 2) = wk; wks[i] = wk; }
#pragma unroll
        for (int e = 0; e < 2; ++e) { u32x4 w_;
#pragma unroll
          for (int j = 0; j < 4; ++j) { const unsigned a_ = e ? (wks[2 * j] >> 16) : (wks[2 * j] & 0xffffu), b_ = e ? (wks[2 * j + 1] >> 16) : (wks[2 * j + 1] & 0xffffu); w_[j] = a_ | (b_ << 16); }
          *(u32x4*)(img + O_KTR + (d0 + e) * PS + te * 16) = w_; }
        float* evw = (float*)(img + O_EV);
        if (te == 0) { evw[d0] = pref[0]; evw[d0 + 1] = pref[1]; evw[128 + d0] = ptot[0] * ipr0; evw[128 + d0 + 1] = ptot[1] * ipr1; }
        if (tid < 256) *(bf16x8*)(img + O_V + v_st1(tid >> 2, (tid & 3) * 8)) = vcur;
        if ((c2 + 2) + 2 < NCHUNK) HGF_LOAD(RA, (c2 + 2) + 2);
      }
      if ((c2 + 1) >= 0) {
        const int c = (c2 + 1); const char* img = lds + 1 * BUF; const float* evl = (const float*)(img + O_EV);
        const int vbV = (int)(uintptr_t)(img + O_V) + v_rd_base_g(lane);
        if (wave >= 4) {
          const int db = wave - 4;
          f32x16 Sp;
#pragma unroll
          for (int r = 0; r < 16; ++r) Sp[r] = S[r] * evl[db * 32 + crow(r, hi)];
#pragma unroll
          for (int g = 0; g < 4; ++g) { u32x2 w; w.x = cvt_pk_bf16(Sp[4 * g], Sp[4 * g + 1]); w.y = cvt_pk_bf16(Sp[4 * g + 2], Sp[4 * g + 3]);
            *(u32x2*)(lds + O_ST + r32 * PQ + (db * 32 + 8 * g + 4 * hi) * 2) = w; }
          asm volatile("s_waitcnt lgkmcnt(0)" ::: "memory");
          if (lane == 0) __hip_atomic_fetch_add(flag, 1u, __ATOMIC_RELEASE, __HIP_MEMORY_SCOPE_WORKGROUP);
          bf16x8 ka[4];
#pragma unroll
          for (int ks = 0; ks < 4; ++ks) ka[ks] = *(const bf16x8*)(img + O_KTR + (db * 32 + r32) * PS + (ks * 16 + hi * 8) * 2);
          const s16x4 l0 = tr_read_g<0>(vbV), h0 = tr_read_g<512>(vbV), l1 = tr_read_g<1024>(vbV), h1 = tr_read_g<1536>(vbV);
          const s16x4 l2 = tr_read_g<2048>(vbV), h2 = tr_read_g<2560>(vbV), l3 = tr_read_g<3072>(vbV), h3 = tr_read_g<3584>(vbV);
          asm volatile("s_waitcnt lgkmcnt(0)" ::: "memory"); SBAR();
          Sp = __builtin_amdgcn_mfma_f32_32x32x16_bf16(ka[0], HGF_PK(l0, h0), Sp, 0, 0, 0);
          Sp = __builtin_amdgcn_mfma_f32_32x32x16_bf16(ka[1], HGF_PK(l1, h1), Sp, 0, 0, 0);
          Sp = __builtin_amdgcn_mfma_f32_32x32x16_bf16(ka[2], HGF_PK(l2, h2), Sp, 0, 0, 0);
          Sp = __builtin_amdgcn_mfma_f32_32x32x16_bf16(ka[3], HGF_PK(l3, h3), Sp, 0, 0, 0);
#pragma unroll
          for (int r = 0; r < 16; ++r) S[r] = Sp[r] * evl[128 + db * 32 + crow(r, hi)];
        } else if (wave < 2) {
          const int tb = wave;
          f32x16 o = f32x16{};
          f32x16 p0 = f32x16{}, p1 = f32x16{};
#pragma unroll
          for (int ks = 0; ks < 8; ++ks) { const int cb = (ks * 16 + hi * 8) * 2;
            const bf16x8 qv = *(const bf16x8*)(img + O_QD + (tb * 32 + r32) * PQ + cb);
            const bf16x8 a0 = *(const bf16x8*)(img + O_KD + r32 * PQ + cb);
            p0 = __builtin_amdgcn_mfma_f32_32x32x16_bf16(a0, qv, p0, 0, 0, 0);
            if (tb) { const bf16x8 a1 = *(const bf16x8*)(img + O_KD + (32 + r32) * PQ + cb); p1 = __builtin_amdgcn_mfma_f32_32x32x16_bf16(a1, qv, p1, 0, 0, 0); } }
          const int tq = tb * 32 + r32;
#pragma unroll
          for (int r = 0; r < 16; ++r) { const int s0 = crow(r, hi); p0[r] = (s0 <= tq) ? p0[r] : 0.f; p1[r] = (32 + s0 <= tq) ? p1[r] : 0.f; }
          bf16x8 pa0, pa1, pa2, pa3;
          HGF_PK4(p0, 0, pa0); HGF_PK4(p0, 8, pa1); HGF_PK4(p1, 0, pa2); HGF_PK4(p1, 8, pa3);
          pv_gen<1024, 512>(o, vbV, pa0, pa1, pa2, pa3);
          float* oi = (float*)(lds + O_OI) + tb * (32 * 36);
#pragma unroll
          for (int r = 0; r < 16; ++r) oi[crow(r, hi) * 36 + r32] = o[r];
          asm volatile("s_waitcnt lgkmcnt(0)" ::: "memory");
          if (lane == 0) __hip_atomic_fetch_add(flag + 1 + tb, 1u, __ATOMIC_RELEASE, __HIP_MEMORY_SCOPE_WORKGROUP);
        } else {
          const int tb = wave - 2;
          { const unsigned want = 4u * (unsigned)(c + 1); while (__hip_atomic_load(flag, __ATOMIC_ACQUIRE, __HIP_MEMORY_SCOPE_WORKGROUP) < want) __builtin_amdgcn_s_sleep(1); }
          f32x16 o = f32x16{};
#pragma unroll
          for (int ks = 0; ks < 8; ++ks) { const bf16x8 a = *(const bf16x8*)(lds + O_ST + r32 * PQ + (ks * 16 + hi * 8) * 2);
            const bf16x8 bb = *(const bf16x8*)(img + O_QD + (tb * 32 + r32) * PQ + (ks * 16 + hi * 8) * 2);
            o = __builtin_amdgcn_mfma_f32_32x32x16_bf16(a, bb, o, 0, 0, 0); }
          { const unsigned want = (unsigned)(c + 1); while (__hip_atomic_load(flag + 1 + tb, __ATOMIC_ACQUIRE, __HIP_MEMORY_SCOPE_WORKGROUP) < want) __builtin_amdgcn_s_sleep(1); }
          const float* oi = (const float*)(lds + O_OI) + tb * (32 * 36) + r32 * 36;
          const int tt = c * 64 + tb * 32 + r32; const int tn = dir ? (SEQ - 1 - tt) : tt;
          bf16_t* orow = OFB + ((size_t)dir * T + (size_t)b * SEQ + tn) * 512 + h * 128 + sl * 32;
#pragma unroll
          for (int g = 0; g < 4; ++g) { const f32x4 iv = *(const f32x4*)(oi + 8 * g + 4 * hi);
            u32x2 w; w.x = cvt_pk_bf16(o[4 * g] + iv.x, o[4 * g + 1] + iv.y); w.y = cvt_pk_bf16(o[4 * g + 2] + iv.z, o[4 * g + 3] + iv.w);
            *(u32x2*)(orow + 8 * g + 4 * hi) = w; }
        }
      }
      __syncthreads();
      }
    }
#undef HGF_LOAD
  }
#undef HGF_PK4
#undef HGF_PK
}

namespace att {
constexpr int NW = 8, KVBLK = 64;
constexpr int SHM_K = 64 * 128, SHM_V = 64 * 64;
constexpr int OFF_V = 0, OFF_K = 3 * SHM_V, SHM_ATTN = OFF_K + 2 * SHM_K;
#define ATT_MFMA(A, B, C, BFMT) __builtin_amdgcn_mfma_scale_f32_32x32x64_f8f6f4(A, B, C, 0, BFMT, 0, 0x7f7f7f7f, 0, 0x7f7f7f7f)
__device__ __forceinline__ i32x8 ld32(const char* p0, const char* p1) { const u32x4 a = *reinterpret_cast<const u32x4*>(p0), b = *reinterpret_cast<const u32x4*>(p1);
  return (i32x8){(int)a.x, (int)a.y, (int)a.z, (int)a.w, (int)b.x, (int)b.y, (int)b.z, (int)b.w}; }
__device__ __forceinline__ void qkt8(f32x16 (&p)[2][2], const char* Ks, const i32x8 (&qr)[2][2], unsigned kb_) {
#pragma unroll
  for (int ks = 0; ks < 2; ++ks)
#pragma unroll
    for (int kb = 0; kb < 2; ++kb) { const char* r0 = Ks + kb * 4096;
      const i32x8 a = ld32(r0 + (kb_ ^ (unsigned)(ks * 64)), r0 + (kb_ ^ (unsigned)(ks * 64 + 16)));
#pragma unroll
      for (int qb = 0; qb < 2; ++qb) p[qb][kb] = (ks == 0) ? ATT_MFMA(a, qr[qb][0], f32x16{}, 0) : ATT_MFMA(a, qr[qb][1], p[qb][kb], 0); }
}
__device__ __forceinline__ void softmax8(f32x16 (&p)[2][2], i32x8 (&pb)[2]) {
#pragma unroll
  for (int qb = 0; qb < 2; ++qb) {
#pragma unroll
    for (int r = 0; r < 16; ++r) { p[qb][0][r] = __builtin_amdgcn_exp2f(p[qb][0][r]); p[qb][1][r] = __builtin_amdgcn_exp2f(p[qb][1][r]); }
#pragma unroll
    for (int v = 0; v < 8; ++v) { const int kb = v >> 2, r0 = 4 * (v & 3); pb[qb][v] = (int)pk4_bf8(p[qb][kb][r0], p[qb][kb][r0 + 1], p[qb][kb][r0 + 2], p[qb][kb][r0 + 3]); } }
}
__device__ __forceinline__ void pvt8(f32x16 (&o)[2][2], f32x16 (&lsum)[2], const char* Vs, const i32x8 (&pb)[2], unsigned vb_) {
  const i32x8 ones = (i32x8){0x38383838, 0x38383838, 0x38383838, 0x38383838, 0x38383838, 0x38383838, 0x38383838, 0x38383838};
#pragma unroll
  for (int dvb = 0; dvb < 2; ++dvb) { const char* r0 = Vs + dvb * 2048;
    const i32x8 a = ld32(r0 + vb_, r0 + (vb_ ^ 16u));
#pragma unroll
    for (int qb = 0; qb < 2; ++qb) o[qb][dvb] = ATT_MFMA(a, pb[qb], o[qb][dvb], 1); }
#pragma unroll
  for (int qb = 0; qb < 2; ++qb) lsum[qb] = ATT_MFMA(ones, pb[qb], lsum[qb], 1);
}

__device__ __forceinline__ void attn_unit(const unsigned char* __restrict__ Qb, const unsigned char* __restrict__ Kh, const unsigned char* __restrict__ VTh, bf16_t* __restrict__ Ob, char* lds) {
  const int tid = otid(), wid = __builtin_amdgcn_readfirstlane(tid >> 6), lane = tid & 63, r32 = lane & 31, hi = lane >> 5;
  char* V_lds = lds + OFF_V; char* K_lds = lds + OFF_K;
  f32x16 lsum[2] = {}; f32x16 o[2][2] = {}; i32x8 qr[2][2];
#pragma unroll
  for (int qb = 0; qb < 2; ++qb) { const char* Qw = (const char*)Qb + (unsigned)((wid * 64 + qb * 32 + r32) * 128 + hi * 32);
#pragma unroll
    for (int ks = 0; ks < 2; ++ks) qr[qb][ks] = ld32(Qw + ks * 64, Qw + ks * 64 + 16); }
  unsigned kgo, vgo, vb_, kb_;
  { const int kr = wid * 8 + (lane >> 3), kc = (lane & 7) ^ ((kr >> 1) & 7);
    kgo = kr * 128 + kc * 16;
    const int vr = (wid & 3) * 16 + (lane >> 2), vc = (lane & 3) ^ ((vr >> 2) & 3);
    vgo = vr * SEQ + vc * 16;
    kb_ = r32 * 128 + (((2 * hi) ^ ((r32 >> 1) & 7)) * 16);
    vb_ = r32 * 64 + (((2 * hi) ^ ((r32 >> 2) & 3)) * 16);
    asm volatile("" : "+v"(kgo), "+v"(vgo), "+v"(vb_), "+v"(kb_)); }
#define DMA16(gbase, voff, laddr) asm volatile("s_mov_b32 m0, %0\n\ts_nop 0\n\tglobal_load_lds_dwordx4 %1, %2" :: "s"(laddr), "v"(voff), "s"(gbase) : "memory", "m0")
  const unsigned K_dma = (unsigned)(size_t)((LAS char*)lds) + OFF_K + wid * 1024, V_dma = (unsigned)(size_t)((LAS char*)lds) + OFF_V + (wid & 3) * 1024;
#define KVDMA(k0, ko, vo) do { const char* kt_ = (const char*)Kh + (size_t)(k0) * 128; DMA16(kt_, kgo, K_dma + (ko)); \
    if (wid < 4) { const char* vt_ = (const char*)VTh + (size_t)(k0); DMA16(vt_, vgo, V_dma + (vo)); } } while (0)
  constexpr int NT = SEQ / KVBLK;
  KVDMA(0, 0, 0);
  asm volatile("s_waitcnt vmcnt(0)" ::: "memory"); __syncthreads();
  int ko = 0, va = 0, vn = SHM_V, vw = 2 * SHM_V;
  f32x16 p[2][2]; i32x8 pb[2];
  if (wid < 4) {
#pragma unroll 1
    for (int t = 0; t < NT; ++t) {
      { const int t1 = (t + 1 < NT ? t + 1 : NT - 1); KVDMA(t1 * KVBLK, ko ^ SHM_K, vn); }
      SBAR();
      qkt8(p, K_lds + ko, qr, kb_);
      softmax8(p, pb);
      pvt8(o, lsum, V_lds + va, pb, vb_);
      asm volatile("s_waitcnt vmcnt(0)" ::: "memory");
      __syncthreads();
      ko ^= SHM_K; { const int tmp = vw; vw = va; va = vn; vn = tmp; }
    }
  } else {
#pragma unroll 1
    for (int t = 0; t < NT; ++t) {
      { const int t1 = (t + 1 < NT ? t + 1 : NT - 1); KVDMA(t1 * KVBLK, ko ^ SHM_K, vn); }
      SBAR();
      if (t > 0) { softmax8(p, pb); pvt8(o, lsum, V_lds + vw, pb, vb_); }
      SBAR();
      qkt8(p, K_lds + ko, qr, kb_);
      asm volatile("s_waitcnt vmcnt(0)" ::: "memory");
      __syncthreads();
      ko ^= SHM_K; { const int tmp = vw; vw = va; va = vn; vn = tmp; }
    }
    softmax8(p, pb); pvt8(o, lsum, V_lds + vw, pb, vb_);
  }
  __syncthreads();
  { const int t2_ = otid(), l2_ = t2_ & 63, r32b = l2_ & 31, hib = l2_ >> 5;
#pragma unroll
    for (int qb = 0; qb < 2; ++qb) {
      const float rl = __builtin_amdgcn_rcpf(lsum[qb][0]);
      char* Ow = (char*)Ob + (unsigned)(((wid * 64 + qb * 32 + r32b) * DM + 4 * hib) * 2);
#pragma unroll
      for (int d0 = 0; d0 < 2; ++d0)
#pragma unroll
        for (int g = 0; g < 4; ++g) { u32x2 w; w.x = cvt_pk_bf16(o[qb][d0][4 * g] * rl, o[qb][d0][4 * g + 1] * rl); w.y = cvt_pk_bf16(o[qb][d0][4 * g + 2] * rl, o[qb][d0][4 * g + 3] * rl);
          *(u32x2*)(Ow + (d0 * 32 + 8 * g) * 2) = w; } } }
#undef DMA16
#undef KVDMA
}
}

__device__ __forceinline__ void phase_attention(const Params& p, char* lds) {
  unsigned char* ws = p.ws;
  const unsigned char* Q8 = (const unsigned char*)(ws + WS_R3); const unsigned char* K8 = Q8 + (size_t)T * NH * 128; const unsigned char* V8T = K8 + (size_t)T * NH * 128;
  bf16_t* mix = (bf16_t*)(ws + WS_R4);
  const int xcd = blockIdx.x & 7, j = blockIdx.x >> 3, nj = gridDim.x >> 3;
#pragma unroll 1
  for (int u_ = j; u_ < 8 * (SEQ / 512); u_ += nj) {
    int u = u_; asm volatile("" : "+s"(u));
    const int bh = xcd * 8 + (u >> 4), qb = u & 15, b = bh >> 3, h = bh & 7;
    att::attn_unit(Q8 + ((size_t)bh * SEQ + qb * 512) * 128, K8 + (size_t)bh * SEQ * 128, V8T + (size_t)bh * DVH * SEQ,
                   mix + ((size_t)b * SEQ + qb * 512) * DM + h * DVH, lds);
  }
}

__device__ __forceinline__ void phase_hgrn_final(const Params& p) {
  const int tid = otid(), lane = tid & 63, wave = tid >> 6;
  unsigned char* ws = p.ws;
  const bf16_t* proj = (const bf16_t*)(ws + WS_R2);
  const bf16_t* OFB = (const bf16_t*)(ws + WS_R1);
  bf16_t* mix = (bf16_t*)(ws + WS_R4);
  const int e0 = (lane & 15) * 8;
  float gn[8];
#pragma unroll
  for (int j = 0; j < 8; ++j) gn[j] = p.hg_out_norm[e0 + j];
  for (int m = blockIdx.x * 8 + wave; m < T; m += gridDim.x * 8) {
    const u32x4 a = *(const u32x4*)(OFB + (size_t)m * 512 + lane * 8), bq = *(const u32x4*)(OFB + ((size_t)T + m) * 512 + lane * 8);
    const u32x4 g = *(const u32x4*)(proj + (size_t)m * NP + C_HG + lane * 8);
    float o[8], hgv[8];
#pragma unroll
    for (int j = 0; j < 4; ++j) { o[2 * j] = bflo(a[j]) + bflo(bq[j]); o[2 * j + 1] = bfhi(a[j]) + bfhi(bq[j]); hgv[2 * j] = bflo(g[j]); hgv[2 * j + 1] = bfhi(g[j]); }
    float ss = 0.f;
#pragma unroll
    for (int j = 0; j < 8; ++j) ss += o[j] * o[j];
    ss += __shfl_xor(ss, 1); ss += __shfl_xor(ss, 2); ss += __shfl_xor(ss, 4); ss += __shfl_xor(ss, 8);
    const float rn = rsqrtf(ss * (1.f / HDV) + EPS);
    u32x4 w;
#pragma unroll
    for (int j = 0; j < 4; ++j) { const float v0 = o[2 * j] * rn * gn[2 * j] * hgv[2 * j], v1 = o[2 * j + 1] * rn * gn[2 * j + 1] * hgv[2 * j + 1];
      w[j] = cvt_pk_bf16(v0, v1); }
    *(u32x4*)(mix + (size_t)m * DM + 512 + lane * 8) = w;
  }
}

__device__ __forceinline__ void phase_router(const Params& p, char* lds) {
  constexpr int RPW = 144, RHL = 64 * RPW, RBUF = 2 * RHL, O_G = 2 * RBUF;
  constexpr int HPW = 272, O_H = 45056;
  const int tid = otid(), lane = tid & 63, wave = tid >> 6, r32 = lane & 31, hi = lane >> 5;
  unsigned char* ws = p.ws;
  unsigned char* XN2 = (unsigned char*)(ws + WS_R1);
  const bf16_t* WRh = (const bf16_t*)(ws + WS_WR); const bf16_t* WRl = WRh + 64 * DM;
  unsigned* cnt = (unsigned*)(ws + WS_CNT);
  int* list = (int*)(ws + WS_LIST);
  float* gate = (float*)(ws + WS_GATE);
  float* gl_ = (float*)(lds + O_G);
  for (int i = tid; i < DM / 4; i += 512) ((f32x4*)gl_)[i] = ((const f32x4*)p.norm_ffn)[i];
  const int wrow = tid >> 3, wg = tid & 7;
  for (int tb = blockIdx.x; tb < T / 256; tb += gridDim.x) {
    const int tok = tb * 256 + wave * 32 + r32;
    unsigned char* xrow = XN2 + (size_t)tok * DM + hi * 8;
    f32x16 acc0 = f32x16{}, acc1 = f32x16{};
    float ss = 0.f;
    const float* hld = p.out + (size_t)(tb * 256 + wave * 32 + (lane >> 4)) * DM + (lane & 15) * 4;
    char* hw_ = lds + O_H + wave * (32 * HPW) + (lane >> 4) * HPW + (lane & 15) * 16;
    const char* hr_ = lds + O_H + wave * (32 * HPW) + r32 * HPW + hi * 32;
    f32x4 hq[2][8];
#pragma unroll
    for (int i = 0; i < 8; ++i) { hq[0][i] = *(const f32x4*)(hld + (size_t)(4 * i) * DM); hq[1][i] = *(const f32x4*)(hld + (size_t)(4 * i) * DM + 64); }
#pragma unroll
    for (int i = 0; i < 8; ++i) *(f32x4*)(hw_ + 4 * i * HPW) = hq[0][i];
    bf16x8 wsh = *(const bf16x8*)(WRh + (size_t)wrow * DM + wg * 8), wsl = *(const bf16x8*)(WRl + (size_t)wrow * DM + wg * 8);
    __syncthreads();
    *(bf16x8*)(lds + wrow * RPW + wg * 16) = wsh; *(bf16x8*)(lds + RHL + wrow * RPW + wg * 16) = wsl;
    wsh = *(const bf16x8*)(WRh + (size_t)wrow * DM + 64 + wg * 8); wsl = *(const bf16x8*)(WRl + (size_t)wrow * DM + 64 + wg * 8);
    __syncthreads();
#pragma unroll 1
    for (int cp = 0; cp < 8; ++cp) {
#pragma unroll
      for (int half = 0; half < 2; ++half) {
        const int c = cp * 2 + half; const char* wb = lds + half * RBUF;
        { const int c2 = c + 2 < 16 ? c + 2 : 15;
#pragma unroll
          for (int i = 0; i < 8; ++i) hq[half][i] = *(const f32x4*)(hld + (size_t)(4 * i) * DM + c2 * 64); }
#pragma unroll
        for (int s4 = 0; s4 < 4; ++s4) { const int j = half * 4 + s4, ks = cp * 8 + j;
          const f32x4 h0 = *(const f32x4*)(hr_ + s4 * 64), h1 = *(const f32x4*)(hr_ + s4 * 64 + 16);
          const f32x4 g0 = *(const f32x4*)(gl_ + ks * 16 + hi * 8), g1 = *(const f32x4*)(gl_ + ks * 16 + hi * 8 + 4);
          ss += (h0.x * h0.x + h0.y * h0.y) + (h0.z * h0.z + h0.w * h0.w) + (h1.x * h1.x + h1.y * h1.y) + (h1.z * h1.z + h1.w * h1.w);
          const f32x4 y0 = h0 * g0, y1 = h1 * g1;
          u32x4 wh; wh.x = cvt_pk_bf16(y0.x, y0.y); wh.y = cvt_pk_bf16(y0.z, y0.w); wh.z = cvt_pk_bf16(y1.x, y1.y); wh.w = cvt_pk_bf16(y1.z, y1.w);
          u32x4 wl; wl.x = cvt_pk_bf16(y0.x - bflo(wh.x), y0.y - bfhi(wh.x)); wl.y = cvt_pk_bf16(y0.z - bflo(wh.y), y0.w - bfhi(wh.y));
          wl.z = cvt_pk_bf16(y1.x - bflo(wh.z), y1.y - bfhi(wh.z)); wl.w = cvt_pk_bf16(y1.z - bflo(wh.w), y1.w - bfhi(wh.w));
          { u32x2 w8; w8.x = pk4_fp8(y0.x, y0.y, y0.z, y0.w); w8.y = pk4_fp8(y1.x, y1.y, y1.z, y1.w); *(u32x2*)(xrow + ks * 16) = w8; }
          const bf16x8 yh = *reinterpret_cast<bf16x8*>(&wh), yl = *reinterpret_cast<bf16x8*>(&wl);
          const char* wa = wb + r32 * RPW + (s4 * 16 + hi * 8) * 2;
          const bf16x8 a0h = *(const bf16x8*)(wa), a0l = *(const bf16x8*)(wa + RHL);
          const bf16x8 a1h = *(const bf16x8*)(wa + 32 * RPW), a1l = *(const bf16x8*)(wa + RHL + 32 * RPW);
          acc0 = __builtin_amdgcn_mfma_f32_32x32x16_bf16(a0h, yh, acc0, 0, 0, 0);
          acc0 = __builtin_amdgcn_mfma_f32_32x32x16_bf16(a0h, yl, acc0, 0, 0, 0);
          acc0 = __builtin_amdgcn_mfma_f32_32x32x16_bf16(a0l, yh, acc0, 0, 0, 0);
          acc1 = __builtin_amdgcn_mfma_f32_32x32x16_bf16(a1h, yh, acc1, 0, 0, 0);
          acc1 = __builtin_amdgcn_mfma_f32_32x32x16_bf16(a1h, yl, acc1, 0, 0, 0);
          acc1 = __builtin_amdgcn_mfma_f32_32x32x16_bf16(a1l, yh, acc1, 0, 0, 0);
        }
#pragma unroll
        for (int i = 0; i < 8; ++i) *(f32x4*)(hw_ + 4 * i * HPW) = hq[half ^ 1][i];
        if (c + 1 < 16) { char* wn = lds + (half ^ 1) * RBUF; *(bf16x8*)(wn + wrow * RPW + wg * 16) = wsh; *(bf16x8*)(wn + RHL + wrow * RPW + wg * 16) = wsl; }
        { const int c2 = c + 2 < 16 ? c + 2 : 15; wsh = *(const bf16x8*)(WRh + (size_t)wrow * DM + c2 * 64 + wg * 8); wsl = *(const bf16x8*)(WRl + (size_t)wrow * DM + c2 * 64 + wg * 8); }
        __syncthreads();
      }
    }
    ss += __shfl_xor(ss, 32);
    const float rs = rsqrtf(ss * (1.f / DM) + EPS);
    float gl[4];
#pragma unroll
    for (int j = 0; j < 4; ++j) gl[j] = __shfl(acc1[j] * rs + p.b_group[j], r32);
    int gi = 0; float gm = gl[0];
    if (gl[1] > gm) { gm = gl[1]; gi = 1; } if (gl[2] > gm) { gm = gl[2]; gi = 2; } if (gl[3] > gm) { gm = gl[3]; gi = 3; }
    const float gw = 1.f / (__expf(gl[0] - gm) + __expf(gl[1] - gm) + __expf(gl[2] - gm) + __expf(gl[3] - gm));
    float l8[8];
#pragma unroll
    for (int j = 0; j < 4; ++j) { const float v = gi == 0 ? acc0[j] : (gi == 1 ? acc0[4 + j] : (gi == 2 ? acc0[8 + j] : acc0[12 + j]));
      const float mine = v * rs + p.b_router[gi * 8 + hi * 4 + j]; const float oth = __shfl_xor(mine, 32);
      l8[j] = hi ? oth : mine; l8[4 + j] = hi ? mine : oth; }
    float l1 = l8[0], l2 = l8[1]; int e1 = 0, e2 = 1;
    if (l2 > l1) { const float t_ = l1; l1 = l2; l2 = t_; e1 = 1; e2 = 0; }
#pragma unroll
    for (int j = 2; j < 8; ++j) { const float lv = l8[j];
      if (lv > l1) { l2 = l1; e2 = e1; l1 = lv; e1 = j; } else if (lv > l2) { l2 = lv; e2 = j; } }
    const float w1 = 1.f / (1.f + __expf(l2 - l1)), w2 = 1.f - w1;
    const int ea = e1 < e2 ? e1 : e2, eb = e1 < e2 ? e2 : e1;
    const float ga = gw * (e1 < e2 ? w1 : w2), gb = gw * (e1 < e2 ? w2 : w1);
    const int bucket = gi * 28 + (ea * 7 - (ea * (ea - 1)) / 2 + (eb - ea - 1));
    unsigned* lc = (unsigned*)(lds + O_G + 4096); unsigned* lbase = lc + 128;
    if (tid < NBUCKET) lc[tid] = 0u;
    __syncthreads();
    unsigned rank = 0u;
    if (hi == 0) { rank = atomicAdd(&lc[bucket], 1u); *(f32x4*)(gate + 4 * (size_t)tok) = (f32x4){ga, gb, rs, 0.f}; }
    __syncthreads();
    if (tid < NBUCKET) { const unsigned c_ = lc[tid]; lbase[tid] = c_ ? atomicAdd(&cnt[tid], c_) : 0u; }
    __syncthreads();
    if (hi == 0) list[(size_t)bucket * T + lbase[bucket] + rank] = tok;
  }
}

__device__ __forceinline__ void build_tile_table(const Params& p, char* lds) {
  unsigned* tab = (unsigned*)(lds + LDS_TAB);
  const unsigned* cnt = (const unsigned*)(p.ws + WS_CNT);
  unsigned* lcnt = tab + 512;
  if (threadIdx.x < NBUCKET) lcnt[threadIdx.x] = cnt[threadIdx.x];
  __syncthreads();
  if (threadIdx.x == 0) {
    int nt = 0;
    for (int bk = 0; bk < NBUCKET; ++bk) { const int c = (int)lcnt[bk]; for (int j = 0; j * 256 < c; ++j) { if (nt < MAXTILES) tab[1 + nt] = (unsigned)bk | ((unsigned)(j * 256) << 8); ++nt; } }
    tab[0] = (unsigned)(nt < MAXTILES ? nt : MAXTILES);
  }
  __syncthreads();
}
__device__ __forceinline__ void bucket_experts(int bucket, int& ea, int& eb) {
  const int grp = bucket / 28; int pi = bucket % 28; int a = 0;
  while (pi >= 7 - a) { pi -= 7 - a; ++a; }
  ea = grp * 8 + a; eb = grp * 8 + a + 1 + pi;
}

__device__ __forceinline__ void phase_gather(const Params& p, char* lds) {
  const int tid = otid(), lane = tid & 63, wave = tid >> 6;
  unsigned char* ws = p.ws;
  const unsigned* tab = (const unsigned*)(lds + LDS_TAB);
  const unsigned* cnt = (const unsigned*)(ws + WS_CNT);
  const int* list = (const int*)(ws + WS_LIST);
  const float* gate = (const float*)(ws + WS_GATE);
  const unsigned char* XN2 = (const unsigned char*)(ws + WS_R1);
  unsigned char* Xg8 = (unsigned char*)(ws + WS_R2);
  int* stok = (int*)(ws + WS_SLOT); float* sga = (float*)(stok + MAXSLOTS); float* sgb = sga + MAXSLOTS; float* srs = sgb + MAXSLOTS;
  const int ntile = (int)tab[0];
  for (int rowi = blockIdx.x * 512 + tid; rowi < ntile * 256; rowi += gridDim.x * 512) {
    const int tile = rowi >> 8, r = rowi & 255; const unsigned te = tab[1 + tile]; const int bk = te & 255, first = te >> 8;
    const int idx = first + r; const int tok = idx < (int)tab[512 + bk] ? list[(size_t)bk * T + idx] : -1;
    const f32x4 gt = tok >= 0 ? *(const f32x4*)(gate + 4 * (size_t)tok) : (f32x4){0.f, 0.f, 0.f, 0.f}; stok[rowi] = tok; sga[rowi] = gt.x; sgb[rowi] = gt.y; srs[rowi] = gt.z * (1.f / WGU_SCALE);
  }
  const int gw = blockIdx.x * 8 + wave, NGW = gridDim.x * 8, nrow = ntile * 256;
  for (int r0 = gw; r0 < nrow; r0 += 8 * NGW) {
    int tk[8];
#pragma unroll
    for (int q = 0; q < 8; ++q) { const int rowi = r0 + q * NGW; tk[q] = -1;
      if (rowi < nrow) { const int tile = rowi >> 8, r = rowi & 255; const unsigned te = tab[1 + tile]; const int bk = te & 255, first = te >> 8; const int idx = first + r;
        if (idx < (int)tab[512 + bk]) tk[q] = list[(size_t)bk * T + idx]; } }
    u32x4 v[8];
#pragma unroll
    for (int q = 0; q < 8; ++q) v[q] = tk[q] >= 0 ? ((const u32x4*)(XN2 + (size_t)tk[q] * DM))[lane] : (u32x4){0u, 0u, 0u, 0u};
#pragma unroll
    for (int q = 0; q < 8; ++q) { const int rowi = r0 + q * NGW; if (rowi < nrow) ((u32x4*)(Xg8 + (size_t)rowi * DM))[lane] = v[q]; }
  }
}

struct MoeOrderGU {
  static constexpr bool GATHER = false; static constexpr bool FP8 = true;
  const char* ldsb; const char* wsb; const int* stok; const char* Wgu; int G, c;
  __device__ unsigned row_off(const pg8::Unit& u, int row) const { const int tok = stok[u.pm * 256 + row]; return tok >= 0 ? (unsigned)(WS_R1 + (size_t)tok * (DM * 2)) : (unsigned)WS_ZROW; }
  __device__ bool next(int i, pg8::Unit& u) const {
    int toff = LDS_TAB; asm volatile("" : "+v"(toff)); const unsigned* tab = (const unsigned*)(ldsb + toff);
    const int L = i * G + c, tile = L >> 2, sub = L & 3; if (tile >= __builtin_amdgcn_readfirstlane((int)tab[0])) return false;
    int ea, eb; bucket_experts(__builtin_amdgcn_readfirstlane((int)(tab[1 + tile] & 255u)), ea, eb);
    const int e = (sub >> 1) ? eb : ea, hh = sub & 1;
    u.pm = tile; u.pn = sub; u.fin = 1; u.A = wsb + WS_R2 + (size_t)tile * 256 * DM; u.B0 = Wgu + ((size_t)e * 512 + hh * 256) * DM; return true;
  }
};
struct EpiGU {
  static constexpr bool PERM = true;
  unsigned char* H; const float* sga; const float* sgb; const float* srs;
  __device__ __forceinline__ void operator()(const f32x4 (&acc)[2][2][4][2], const pg8::Unit& u, int wr, int wc, int fr, int fq) const {
    const int which = u.pn >> 1, hh = u.pn & 1; const float* sg = which ? sgb : sga;
    const int row0 = u.pm * 256 + wr * 64 + fr, col0 = which * 256 + hh * 128 + wc * 32 + 8 * fq;
#pragma unroll
    for (int ai = 0; ai < 2; ++ai)
#pragma unroll
      for (int m = 0; m < 4; ++m) { const int row = row0 + ai * 128 + m * 16; const float gw = sg[row], rsr = srs[row];
        float hv[8];
#pragma unroll
        for (int n = 0; n < 2; ++n)
#pragma unroll
          for (int j = 0; j < 4; ++j) { const float gt = acc[ai][0][m][n][j] * rsr, up = acc[ai][1][m][n][j] * rsr; hv[4 * n + j] = gt * sigmoidf_(gt) * up * (gw * H_SCALE); }
        u32x2 w; w.x = pk4_fp8(hv[0], hv[1], hv[2], hv[3]); w.y = pk4_fp8(hv[4], hv[5], hv[6], hv[7]);
        *(u32x2*)(H + (size_t)row * 512 + col0) = w; }
  }
};
struct MoeOrderD {
  static constexpr bool GATHER = false; static constexpr bool FP8 = true;
  __device__ unsigned row_off(const pg8::Unit&, int) const { return 0u; }
  const char* ldsb; const char* Hb; const char* Wd; int G, c;
  __device__ bool next(int i, pg8::Unit& u) const {
    int toff = LDS_TAB; asm volatile("" : "+v"(toff)); const unsigned* tab = (const unsigned*)(ldsb + toff);
    const int P = (i >> 1) * G + c, part = i & 1, tile = P >> 2, pn = P & 3; if (tile >= __builtin_amdgcn_readfirstlane((int)tab[0])) return false;
    int ea, eb; bucket_experts(__builtin_amdgcn_readfirstlane((int)(tab[1 + tile] & 255u)), ea, eb);
    const int e = part ? eb : ea;
    u.pm = tile; u.pn = pn; u.fin = part; u.A = Hb + ((size_t)tile * 256 * 512 + part * 256); u.B0 = Wd + ((size_t)e * DM + pn * 256) * DEXP; return true;
  }
};
struct EpiDown {
  static constexpr bool PERM = false;
  float* out; const int* stok;
  __device__ __forceinline__ void operator()(const f32x4 (&acc)[2][2][4][2], const pg8::Unit& u, int wr, int wc, int fr, int fq) const {
    const int row0 = u.pm * 256 + wr * 64 + fr, col0 = u.pn * 256 + wc * 32 + 4 * fq;
#pragma unroll
    for (int ai = 0; ai < 2; ++ai)
#pragma unroll
      for (int m = 0; m < 4; ++m) { const int tok = stok[row0 + ai * 128 + m * 16];
        if (tok >= 0) { float* o = out + (size_t)tok * DM + col0;
#pragma unroll
          for (int bj = 0; bj < 2; ++bj)
#pragma unroll
            for (int n = 0; n < 2; ++n) { f32x4* q = (f32x4*)(o + bj * 128 + n * 16); *q = *q + acc[ai][bj][m][n] * (1.f / (WD_SCALE * H_SCALE)); } } }
  }
};


#define XB_TMO      128
#define XB_XCNT(j)  (256  + 64 * (j))
#define XB_XSUB(j)  (1280 + 64 * (j))
#define XB_XGEN(j)  (2304 + 64 * (j))
#define XB_TOP      3328
#define XB_TOPGEN   3392
#define XCD_BAR_WORDS 3456
#define XB_SPIN_CAP (1u << 22)
__device__ __forceinline__ unsigned xb_ld(unsigned* p)              { return __hip_atomic_load(p, __ATOMIC_RELAXED, __HIP_MEMORY_SCOPE_AGENT); }
__device__ __forceinline__ unsigned xb_add(unsigned* p, unsigned v) { return __hip_atomic_fetch_add(p, v, __ATOMIC_RELAXED, __HIP_MEMORY_SCOPE_AGENT); }
__device__ __forceinline__ unsigned xb_xcc_id() { return (unsigned)__builtin_amdgcn_s_getreg((3 << 11) | 20) & 0xFu; }
#define XB_SPIN(cond, bar) do { unsigned _sp = 0; while (cond) { __builtin_amdgcn_s_sleep(1); \
    if ((++_sp & 255u) == 0u) { if (xb_ld(&(bar)[XB_TMO])) break; if (_sp > XB_SPIN_CAP) { atomicAdd(&(bar)[XB_TMO], 1u); break; } } } } while (0)
struct XcdBarrier { unsigned* bar; unsigned x; volatile LAS unsigned* st; };
__device__ __forceinline__ XcdBarrier xcd_barrier_post(unsigned* bar, volatile LAS unsigned* st) {
    XcdBarrier b; b.bar = bar; b.x = xb_xcc_id(); b.st = st;
    if (threadIdx.x == 0) (void)xb_add(&bar[XB_XCNT(b.x)], 1u);
    return b;
}
__device__ __forceinline__ void xcd_barrier_complete(unsigned* bar, unsigned x, unsigned& nloc, unsigned& nx) {
    const unsigned G = gridDim.x * gridDim.y * gridDim.z;
    unsigned sum, cnt, mine, sp = 0u;
    for (;;) {
        sum = 0u; cnt = 0u; mine = 0u;
#pragma unroll
        for (unsigned j = 0; j < 16; ++j) { const unsigned c = xb_ld(&bar[XB_XCNT(j)]); sum += c; cnt += (c > 0u) ? 1u : 0u; mine = (j == x) ? c : mine; }
        if (sum == G) break;
        __builtin_amdgcn_s_sleep(1);
        if ((++sp & 255u) == 0u) { if (xb_ld(&bar[XB_TMO])) break; if (sp > XB_SPIN_CAP) { atomicAdd(&bar[XB_TMO], 1u); break; } }
    }
    nloc = mine > 0u ? mine : 1u; nx = cnt > 0u ? cnt : 1u;
}
__device__ __forceinline__ void xcd_barrier(const XcdBarrier& b) {
    asm volatile("s_waitcnt vmcnt(0)" ::: "memory");
    __syncthreads();
    if (threadIdx.x == 0) {
        unsigned* bar = b.bar;
        __builtin_amdgcn_s_waitcnt(0);
        unsigned nloc = b.st[0], nx = b.st[1];
        if (nloc == 0u) { xcd_barrier_complete(bar, b.x, nloc, nx); b.st[0] = nloc; b.st[1] = nx; }
        const unsigned old = xb_add(&bar[XB_XSUB(b.x)], 1u);
        const unsigned gen = old / nloc;
        if (old + 1u == (gen + 1u) * nloc) {
            __builtin_amdgcn_fence(__ATOMIC_RELEASE, "agent");
            asm volatile("s_waitcnt vmcnt(0)" ::: "memory");
            const unsigned og = xb_add(&bar[XB_TOP], 1u);
            const unsigned tg = og / nx;
            if (og + 1u == (tg + 1u) * nx) xb_add(&bar[XB_TOPGEN], 1u);
            else XB_SPIN(xb_ld(&bar[XB_TOPGEN]) == tg, bar);
            __builtin_amdgcn_fence(__ATOMIC_ACQUIRE, "agent");
            xb_add(&bar[XB_XGEN(b.x)], 1u);
            asm volatile("s_waitcnt vmcnt(0)" ::: "memory");
        } else {
            XB_SPIN(xb_ld(&bar[XB_XGEN(b.x)]) == gen, bar);
            __builtin_amdgcn_fence(__ATOMIC_ACQUIRE, "agent");
            asm volatile("s_waitcnt vmcnt(0)" ::: "memory");
        }
    }
    __syncthreads();
}

__global__ void __launch_bounds__(512, 2) fwd_megakernel(Params p) {
  extern __shared__ __attribute__((aligned(16))) char lds[];
  cg::grid_group grid = cg::this_grid();
  unsigned char* ws = p.ws;
  LAS unsigned char* lds3 = (LAS unsigned char*)lds;
  const int G = gridDim.x, c = blockIdx.x;
  if (threadIdx.x < 2) ((volatile LAS unsigned*)(lds3 + LDS_BARST))[threadIdx.x] = 0u;
  __syncthreads();
  const XcdBarrier xbar = xcd_barrier_post((unsigned*)(ws + WS_BAR), (volatile LAS unsigned*)(lds3 + LDS_BARST));
#define GRID_BAR() xcd_barrier(xbar)

  phase_prep(p, lds);
  if (p.ws == nullptr) grid.sync();
  GRID_BAR();
  { pg8::Gemm g{DM, DM, DM}; pg8::StaticOrder S; S.init(ws + WS_R1, ws + WS_WIN, T, NP, DM, DM, G, c);
    pg8::EpiBf16 E{(bf16_t*)(ws + WS_R2), NP, (const float*)(ws + WS_OML)};
    pg8::gemm_phase<pg8::EpiBf16, pg8::StaticOrder>(lds3, g, S, E); }
  GRID_BAR();
#if ENABLE_ATTN
  phase_mla_prep(p, lds);
#endif
  GRID_BAR();
#if ENABLE_HGRN
  phase_hgrn_fused(p, lds);
#endif
#if ENABLE_ATTN
  phase_attention(p, lds);
#else
  for (size_t i = (size_t)blockIdx.x * 512 + threadIdx.x; i < (size_t)T * 64; i += (size_t)gridDim.x * 512) { const size_t m = i >> 6, cc = i & 63; ((u32x4*)(ws + WS_R4 + m * 2048))[cc] = (u32x4){0u, 0u, 0u, 0u}; }
#endif
  GRID_BAR();
#if ENABLE_HGRN
  phase_hgrn_final(p);
#else
  for (size_t i = (size_t)blockIdx.x * 512 + threadIdx.x; i < (size_t)T * 64; i += (size_t)gridDim.x * 512) { const size_t m = i >> 6, cc = i & 63; ((u32x4*)(ws + WS_R4 + m * 2048 + 1024))[cc] = (u32x4){0u, 0u, 0u, 0u}; }
#endif
  GRID_BAR();
  { pg8::Gemm g{DM, DM, DM}; pg8::StaticOrder S; S.init(ws + WS_R4, ws + WS_WOUT, T, DM, DM, DM, G, c);
    pg8::EpiResid E{p.x, p.out};
    pg8::gemm_phase<pg8::EpiResid, pg8::StaticOrder>(lds3, g, S, E); }
#if ENABLE_MOE
  GRID_BAR();
  phase_router(p, lds);
  GRID_BAR();
  build_tile_table(p, lds);
  phase_gather(p, lds);
  GRID_BAR();
  { pg8::Gemm g{DM / 2, DM / 2, DM / 2}; MoeOrderGU S{(const char*)lds, (const char*)ws, (const int*)(ws + WS_SLOT), (const char*)(ws + WS_WGU), G, c};
    EpiGU E{(unsigned char*)(ws + WS_R3), (const float*)(ws + WS_SLOT) + MAXSLOTS, (const float*)(ws + WS_SLOT) + 2 * MAXSLOTS, (const float*)(ws + WS_SLOT) + 3 * MAXSLOTS};
    pg8::gemm_phase<EpiGU, MoeOrderGU>(lds3, g, S, E); }
  GRID_BAR();
  { pg8::Gemm g{DEXP / 2, 512 / 2, DEXP / 2}; MoeOrderD S{(const char*)lds, (const char*)(ws + WS_R3), (const char*)(ws + WS_WD), G, c};
    EpiDown E{p.out, (const int*)(ws + WS_SLOT)};
    pg8::gemm_phase<EpiDown, MoeOrderD>(lds3, g, S, E); }
#endif
}

extern "C" void kernel_launch(void* const* d_in, const int* in_sizes, int n_in, void* d_out, int out_size,
                              void* d_ws, size_t ws_size, hipStream_t stream) {
  static int grid_blocks = 0;
  if (grid_blocks == 0) {
    if (n_in != 20 || in_sizes[0] != T * DM || out_size != T * DM || ws_size < WS_END) {
      fprintf(stderr, "kernel_launch: unexpected shapes: n_in %d in0 %d out %d ws %zu (need %zu)\n", n_in, n_in > 0 ? in_sizes[0] : -1, out_size, ws_size, (size_t)WS_END); grid_blocks = -1; return; }
    int dev = 0, cus = 0, per_cu = 0;
    (void)hipGetDevice(&dev);
    (void)hipDeviceGetAttribute(&cus, hipDeviceAttributeMultiprocessorCount, dev);
    if (hipFuncSetAttribute((const void*)fwd_megakernel, hipFuncAttributeMaxDynamicSharedMemorySize, LDS_BYTES) != hipSuccess) { fprintf(stderr, "kernel_launch: hipFuncSetAttribute failed\n"); grid_blocks = -1; return; }
    (void)hipOccupancyMaxActiveBlocksPerMultiprocessor(&per_cu, (const void*)fwd_megakernel, 512, LDS_BYTES);
    fprintf(stderr, "kernel_launch: cus %d per_cu %d ws %zu\n", cus, per_cu, ws_size);
    if (per_cu < 1) { grid_blocks = -1; return; }
    grid_blocks = cus;
    if (grid_blocks % 8) grid_blocks -= grid_blocks % 8;
  }
  if (grid_blocks < 0) return;
  if (hipMemsetAsync(d_ws, 0, 1 * MiB, stream) != hipSuccess) { fprintf(stderr, "kernel_launch: memset failed\n"); return; }
  Params p{};
  const float** pf = (const float**)&p;
  for (int i = 0; i < 20; ++i) pf[i] = (const float*)d_in[i];
  p.out = (float*)d_out; p.ws = (unsigned char*)d_ws;
  void* args[] = {&p};
  hipError_t e = hipLaunchCooperativeKernel((void*)fwd_megakernel, dim3(grid_blocks), dim3(512), args, LDS_BYTES, stream);
  if (e != hipSuccess) fprintf(stderr, "cooperative launch failed: %s (grid %d)\n", hipGetErrorString(e), grid_blocks);
}
```

```cpp
#include <hip/hip_runtime.h>
#include <hip/hip_cooperative_groups.h>
#include <cstdio>
#include <cstdint>
namespace cg = cooperative_groups;

#ifndef ENABLE_ATTN
#define ENABLE_ATTN 1
#endif
#ifndef ENABLE_HGRN
#define ENABLE_HGRN 1
#endif
#ifndef ENABLE_MOE
#define ENABLE_MOE 1
#endif

#define LAS __attribute__((address_space(3)))
typedef unsigned short bf16_t;
typedef short bf16x8 __attribute__((ext_vector_type(8)));
typedef short s16x4 __attribute__((ext_vector_type(4)));
typedef float f32x2 __attribute__((ext_vector_type(2)));
typedef float f32x4 __attribute__((ext_vector_type(4)));
typedef float f32x8 __attribute__((ext_vector_type(8)));
typedef float f32x16 __attribute__((ext_vector_type(16)));
typedef unsigned u32x2 __attribute__((ext_vector_type(2)));
typedef unsigned u32x4 __attribute__((ext_vector_type(4)));
typedef int i32x4 __attribute__((ext_vector_type(4)));
typedef int i32x8 __attribute__((ext_vector_type(8)));
typedef unsigned u32x6 __attribute__((ext_vector_type(6)));

constexpr int BATCH = 8, SEQ = 8192, DM = 1024, T = BATCH * SEQ;
constexpr int NH = 8, QLORA = 256, KVLORA = 128, DROPE = 32, DNOPE = 64, DQK = 96, DVH = 64;
constexpr int HGH = 4, HDK = 128, HDV = 128, NCHUNK = SEQ / 64;
constexpr int N_IN = 2976, NP = 3072;
constexpr int C_HQ = 512, C_FF = 1024, C_FB = 1536, C_HI = 2048, C_HG = 2560, C_KVL = 256, C_KR = 384;
constexpr int NEXP = 32, DEXP = 256, NBUCKET = 112, MAXTILES = 384;
constexpr float EPS = 1e-6f;
constexpr float WD_SCALE = 16.f, H_SCALE = 16.f;
constexpr float WGU_SCALE = 32.f;
constexpr float QS2 = 4.f * 0.38372444f;
constexpr float QSCALE = 0.10206207261596577f * 1.4426950408889634f;

constexpr size_t MiB = 1u << 20;
constexpr size_t WS_CNT = 0;
constexpr size_t WS_ZROW = 256 * 1024;
constexpr size_t WS_OML = 768 * 1024;
constexpr size_t WS_BAR = 512 * 1024;
constexpr size_t WS_WIN = 1 * MiB;
constexpr size_t WS_WUQ = 7 * MiB;
constexpr size_t WS_WUKV = WS_WUQ + 512 * 1024;
constexpr size_t WS_WOUT = 8 * MiB;
constexpr size_t WS_WGU = 10 * MiB;
constexpr size_t WS_WD = 42 * MiB;
constexpr size_t WS_ROPE = 58 * MiB;
constexpr size_t WS_EV = 59 * MiB;
constexpr size_t WS_LIST = 67 * MiB;
constexpr size_t WS_GATE = 95 * MiB;
constexpr size_t WS_SLOT = 96 * MiB;
constexpr size_t WS_WR = 98 * MiB;
constexpr size_t WS_R1 = 100 * MiB;
constexpr size_t WS_R2 = 228 * MiB;
constexpr size_t WS_R3 = 612 * MiB;
constexpr size_t WS_R4 = 868 * MiB;
constexpr size_t WS_H16 = WS_R2 + 256 * MiB;
constexpr size_t WS_END = 996 * MiB;
constexpr int MAXSLOTS = 98304;

constexpr int LDS_BYTES = 143360;
constexpr int LDS_BARST = 143360 - 64;
constexpr int LDS_TAB = 131072;

struct Params {
  const float* x; const float* norm_mix; const float* w_in; const float* q_lat_norm; const float* kv_lat_norm; const float* w_uq; const float* w_ukv;
  const float* q_norm; const float* k_norm; const float* lb_logits; const float* hg_out_norm; const float* w_out; const float* norm_ffn;
  const float* w_group; const float* b_group; const float* w_router; const float* b_router; const float* w_gate; const float* w_up; const float* w_down;
  float* out; unsigned char* ws;
};

typedef float f32x2_t_ __attribute__((ext_vector_type(2))); typedef __bf16 bf16x2_t_ __attribute__((ext_vector_type(2)));
__device__ __forceinline__ unsigned cvt_pk_bf16(float lo, float hi) { f32x2_t_ v = {lo, hi}; bf16x2_t_ b = __builtin_convertvector(v, bf16x2_t_); return __builtin_bit_cast(unsigned, b); }
__device__ __forceinline__ float bf2f(unsigned short b) { return __uint_as_float(((unsigned)b) << 16); }
__device__ __forceinline__ unsigned pk4_fp8(float a, float b, float c, float d) { int w = 0;
  a = __builtin_amdgcn_fmed3f(a, -448.f, 448.f); b = __builtin_amdgcn_fmed3f(b, -448.f, 448.f); c = __builtin_amdgcn_fmed3f(c, -448.f, 448.f); d = __builtin_amdgcn_fmed3f(d, -448.f, 448.f);
  w = __builtin_amdgcn_cvt_pk_fp8_f32(a, b, w, false); w = __builtin_amdgcn_cvt_pk_fp8_f32(c, d, w, true); return (unsigned)w; }
__device__ __forceinline__ unsigned pk4_fp8_nc(float a, float b, float c, float d) { int w = 0; w = __builtin_amdgcn_cvt_pk_fp8_f32(a, b, w, false); w = __builtin_amdgcn_cvt_pk_fp8_f32(c, d, w, true); return (unsigned)w; }
__device__ __forceinline__ u32x6 cvt32_fp6(const f32x16& a, const f32x16& b) { u32x6 r;
  asm volatile("v_cvt_scalef32_2xpk16_fp6_f32 %0, %1, %2, 1.0" : "=&v"(r) : "v"(a), "v"(b)); return r; }
__device__ __forceinline__ unsigned pk4_bf8(float a, float b, float c, float d) { int w; asm("" : "=v"(w) : "v"(a));
  w = __builtin_amdgcn_cvt_pk_bf8_f32(a, b, w, false); w = __builtin_amdgcn_cvt_pk_bf8_f32(c, d, w, true); return (unsigned)w; }
__device__ __forceinline__ float bflo(unsigned w) { return __uint_as_float(w << 16); }
__device__ __forceinline__ float bfhi(unsigned w) { return __uint_as_float(w & 0xffff0000u); }
__device__ __forceinline__ unsigned short f2bf(float f) { return (unsigned short)(cvt_pk_bf16(f, 0.f) & 0xffffu); }
__device__ __forceinline__ int crow(int r, int hi) { return (r & 3) + 8 * (r >> 2) + 4 * hi; }
__device__ __forceinline__ float wave_sum(float v) {
#pragma unroll
  for (int o = 1; o < 64; o <<= 1) v += __shfl_xor(v, o);
  return v;
}
__device__ __forceinline__ float sigmoidf_(float x) { return __builtin_amdgcn_rcpf(1.f + __expf(-x)); }
__device__ __forceinline__ int otid() { int t = threadIdx.x; asm volatile("" : "+v"(t)); return t; }
#define LDS_WAIT() asm volatile("s_waitcnt lgkmcnt(0)" ::: "memory")
#define VM_WAIT() asm volatile("s_waitcnt vmcnt(0)" ::: "memory")
#define SBAR() __builtin_amdgcn_sched_barrier(0)

namespace pg8 {
constexpr int PG8_VOOFF = 131072 + 3072;
constexpr int BM = 256, BK = 64, HALF = 128, HTB = HALF * BK * 2, STAGE_BYTES = 8 * HTB, NXCD = 8, WGM = 8;
__host__ __device__ __forceinline__ int lds_byte(int r, int c) { const int st = (r >> 4) * 2 + (c >> 5), rr = r & 15, cc = c & 31, ob = rr * 64 + cc * 2; return st * 1024 + (ob ^ (((ob >> 9) & 1) << 5)); }
__host__ __device__ __forceinline__ void stage_rc(int b, int& R, int& C) { const int st = b / 1024, sb = b % 1024, swz = sb ^ (((sb >> 9) & 1) << 5); R = (st >> 1) * 16 + swz / 64; C = (st & 1) * 32 + (swz % 64) / 2; }
__host__ __device__ __forceinline__ int perm32(int rho) { const int n = rho >> 4, i = rho & 15; return 8 * (i >> 2) + 4 * n + (i & 3); }

struct Unit { int pm, pn, fin; const char* A; const char* B0; };
struct Gemm { int K, lda, ldb; };

template <class Epi, class Sched>
__device__ __forceinline__ void gemm_phase(LAS unsigned char* lds, const Gemm g, const Sched& S, const Epi& E) {
    const int tid = otid(), wid = __builtin_amdgcn_readfirstlane(tid >> 6), lane = tid & 63, wr = wid >> 2, wc = wid & 3, fr = lane & 15, fq = lane >> 4;
    int nt = g.K / BK; asm volatile("" : "+s"(nt));
    unsigned voffA[2], voffB[2];
#pragma unroll
    for (int i = 0; i < 2; ++i) { int R, C; stage_rc(tid * 16 + i * 8192, R, C); const int Rb = Epi::PERM ? ((R & ~31) + perm32(R & 31)) : R;
        voffA[i] = (unsigned)(R * g.lda + C) * 2u; voffB[i] = (unsigned)(Rb * g.ldb + C) * 2u; }
    if constexpr (Sched::FP8) { *(LAS u32x4*)(lds + PG8_VOOFF + (otid() << 4)) = (u32x4){voffA[0], voffA[1], voffB[0], voffB[1]}; }
    const size_t kstep = (size_t)(BK * 2);
    const size_t hstepA = Sched::GATHER ? (size_t)0 : (size_t)HALF * g.lda * 2, hstepB = (size_t)HALF * g.ldb * 2;
    unsigned cg0[2], cg1[2], ng0[2], ng1[2];
#define PG8_GOFFS(u, o0, o1) do { const int t_ = otid(); _Pragma("unroll") for (int i = 0; i < 2; ++i) { int R, C; stage_rc(t_ * 16 + i * 8192, R, C); \
        o0[i] = S.row_off(u, R) + (unsigned)C * 2u; o1[i] = S.row_off(u, HALF + R) + (unsigned)C * 2u; } } while (0)
    const unsigned ldsw = (unsigned)wid * 1024u;
    const int aoff = lds_byte(wr * 64 + fr, fq * 8), boff = lds_byte(wc * 32 + fr, fq * 8);
#define PG8_SA(b, h) (((b) * 2 + (h)) * HTB)
#define PG8_SB(b, h) ((4 + (b) * 2 + (h)) * HTB)
#define PG8_STAGE(bufoff, gbase, voff) do { unsigned vo_[2] = {(voff)[0], (voff)[1]}; \
        if constexpr (Sched::FP8) { const u32x4 pk_ = *(const LAS u32x4*)(lds + PG8_VOOFF + (otid() << 4)); const bool isb_ = (const void*)(voff) == (const void*)voffB; vo_[0] = isb_ ? pk_.z : pk_.x; vo_[1] = isb_ ? pk_.w : pk_.y; } \
        _Pragma("unroll") for (int _i = 0; _i < 2; ++_i) \
        __builtin_amdgcn_global_load_lds((const unsigned*)((const char*)(gbase) + vo_[_i]), (LAS unsigned*)(lds + (bufoff) + ldsw + _i * 8192), 16, 0, 0); } while (0)
#define PG8_LDA_M(dst, b, h, m0, nm) do { _Pragma("unroll") for (int m = 0; m < nm; ++m) { dst[m].lo = *(const LAS i32x4*)(lds + PG8_SA(b, h) + aoff + (m0 + m) * 2048); dst[m].hi = *(const LAS i32x4*)(lds + PG8_SA(b, h) + aoff + (m0 + m) * 2048 + 1024); } } while (0)
#define PG8_LDA(dst, b, h) do { if constexpr (Sched::FP8) PG8_LDA_M(dst, b, h, 0, 2); else PG8_LDA_M(dst, b, h, 0, 4); } while (0)
#define PG8_LDB(dst, b, h) do { _Pragma("unroll") for (int n = 0; n < 2; ++n) { dst[n].lo = *(const LAS i32x4*)(lds + PG8_SB(b, h) + boff + n * 2048); dst[n].hi = *(const LAS i32x4*)(lds + PG8_SB(b, h) + boff + n * 2048 + 1024); } } while (0)
#define PG8_H(x, k) __builtin_bit_cast(bf16x8, (k) ? (x).hi : (x).lo)
#define PG8_MMA8(ai, bj, At, Bt, m0) do { _Pragma("unroll") for (int m = 0; m < 2; ++m) _Pragma("unroll") for (int n = 0; n < 2; ++n) \
        acc[ai][bj][m0 + m][n] = __builtin_amdgcn_mfma_scale_f32_16x16x128_f8f6f4(Bt[n], At[m], acc[ai][bj][m0 + m][n], 0, 0, 0, 0x7f7f7f7f, 0, 0x7f7f7f7f); } while (0)
#define PG8_MMA2(ai, At, Bt0, Bt1, b, h) do { __builtin_amdgcn_s_setprio(1); \
        if constexpr (Sched::FP8) { PG8_MMA8(ai, 0, At, Bt0, 0); PG8_MMA8(ai, 1, At, Bt1, 0); __builtin_amdgcn_s_setprio(0); PG8_LDA_M(At, b, h, 2, 2); PG8_WAIT_L(0); PG8_SCHED; __builtin_amdgcn_s_setprio(1); \
            PG8_MMA8(ai, 0, At, Bt0, 2); PG8_MMA8(ai, 1, At, Bt1, 2); } \
        else { _Pragma("unroll") for (int bj = 0; bj < 2; ++bj) _Pragma("unroll") for (int m = 0; m < 4; ++m) _Pragma("unroll") for (int n = 0; n < 2; ++n) _Pragma("unroll") for (int k = 0; k < 2; ++k) \
        acc[ai][bj][m][n] = __builtin_amdgcn_mfma_f32_16x16x32_bf16(PG8_H(bj ? Bt1[n] : Bt0[n], k), PG8_H(At[m], k), acc[ai][bj][m][n], 0, 0, 0); } __builtin_amdgcn_s_setprio(0); } while (0)
#define PG8_WAIT_V(n) asm volatile("s_waitcnt vmcnt(" #n ")" ::: "memory")
#define PG8_WAIT_L(n) asm volatile("s_waitcnt lgkmcnt(" #n ")" ::: "memory")
#define PG8_BAR __builtin_amdgcn_s_barrier()
#define PG8_SCHED __builtin_amdgcn_sched_barrier(0)
    Unit cur, nxt; int ui = 0;
    if (!S.next(0, cur)) return;
    f32x4 acc[2][2][4][2];
#pragma unroll
    for (int a = 0; a < 2; ++a)
#pragma unroll
        for (int b = 0; b < 2; ++b)
#pragma unroll
            for (int m = 0; m < 4; ++m)
#pragma unroll
                for (int n = 0; n < 2; ++n) acc[a][b][m][n] = (f32x4){0.f, 0.f, 0.f, 0.f};
    i32x8 At[4], B0[2], B1[2];
    const char* cA = cur.A; const char* cBq = cur.B0;
    if constexpr (Sched::GATHER) { PG8_GOFFS(cur, cg0, cg1); } else {
#pragma unroll
        for (int i = 0; i < 2; ++i) { cg0[i] = voffA[i]; cg1[i] = voffA[i]; } }
    {
        const char* cB = cur.B0;
        PG8_STAGE(PG8_SB(0, 0), cB, voffB); PG8_STAGE(PG8_SB(0, 1), cB + hstepB, voffB); PG8_STAGE(PG8_SA(0, 0), cA, cg0); PG8_STAGE(PG8_SA(0, 1), cA + hstepA, cg1);
        if (wr == 1) PG8_BAR;
        PG8_WAIT_V(2); PG8_BAR;
        PG8_STAGE(PG8_SB(1, 0), cB + kstep, voffB); PG8_STAGE(PG8_SA(1, 0), cA + kstep, cg0); PG8_STAGE(PG8_SB(1, 1), cB + hstepB + kstep, voffB);
        PG8_WAIT_V(6); PG8_BAR;
    }
    for (;;) {
        const bool has_next = S.next(ui + 1, nxt);
        const char* nA = has_next ? nxt.A : cA; const char* nB = has_next ? nxt.B0 : cBq;
        if constexpr (Sched::GATHER) { if (has_next) { PG8_GOFFS(nxt, ng0, ng1); } else {
#pragma unroll
            for (int i = 0; i < 2; ++i) { ng0[i] = cg0[i]; ng1[i] = cg1[i]; } } }
        for (int t = 0; t < nt; t += 2) {
            const bool last = (t == nt - 2);
            const char* a1 = cA + (size_t)(t + 1) * kstep;
            const char* a2 = last ? nA : cA + (size_t)(t + 2) * kstep; const char* b2 = last ? nB : cBq + (size_t)(t + 2) * kstep;
            const char* a3 = a2 + kstep; const char* b3 = b2 + kstep;
            unsigned s0[2], s1[2];
#pragma unroll
            for (int i = 0; i < 2; ++i) { s0[i] = (Sched::GATHER && last) ? ng0[i] : cg0[i]; s1[i] = (Sched::GATHER && last) ? ng1[i] : cg1[i]; }
            PG8_LDB(B0, 0, 0); PG8_LDB(B1, 0, 1); PG8_SCHED; PG8_LDA(At, 0, 0); PG8_STAGE(PG8_SA(1, 1), a1 + hstepA, cg1);
            PG8_WAIT_V(8); PG8_WAIT_L(0); PG8_BAR; PG8_MMA2(0, At, B0, B1, 0, 0); PG8_BAR; PG8_SCHED;
            PG8_LDA(At, 0, 1); PG8_STAGE(PG8_SB(0, 0), b2, voffB); PG8_STAGE(PG8_SB(0, 1), b2 + hstepB, voffB); PG8_STAGE(PG8_SA(0, 0), a2, s0);
            PG8_WAIT_V(8); PG8_WAIT_L(0); PG8_BAR; PG8_MMA2(1, At, B0, B1, 0, 1); PG8_BAR; PG8_SCHED;
            PG8_LDB(B0, 1, 0); PG8_LDB(B1, 1, 1); PG8_SCHED; PG8_LDA(At, 1, 0); PG8_STAGE(PG8_SA(0, 1), a2 + hstepA, s1);
            PG8_WAIT_V(8); PG8_WAIT_L(0); PG8_BAR; PG8_MMA2(0, At, B0, B1, 1, 0); PG8_BAR; PG8_SCHED;
            PG8_LDA(At, 1, 1); PG8_STAGE(PG8_SB(1, 0), b3, voffB); PG8_STAGE(PG8_SB(1, 1), b3 + hstepB, voffB); PG8_STAGE(PG8_SA(1, 0), a3, s0);
            PG8_WAIT_V(8); PG8_WAIT_L(0); PG8_BAR; PG8_MMA2(1, At, B0, B1, 1, 1); PG8_BAR; PG8_SCHED;
        }
        if (wr == 0) PG8_BAR;
        if (cur.fin) { const int l2_ = otid() & 63; E(acc, cur, wr, wc, l2_ & 15, l2_ >> 4); }
        if (!has_next) break;
        if (cur.fin)
#pragma unroll
        for (int a = 0; a < 2; ++a)
#pragma unroll
            for (int b = 0; b < 2; ++b)
#pragma unroll
                for (int m = 0; m < 4; ++m)
#pragma unroll
                    for (int n = 0; n < 2; ++n) acc[a][b][m][n] = (f32x4){0.f, 0.f, 0.f, 0.f};
        cur = nxt; cA = nA; cBq = nB; ++ui;
        if constexpr (Sched::GATHER) {
#pragma unroll
            for (int i = 0; i < 2; ++i) { cg0[i] = ng0[i]; cg1[i] = ng1[i]; } }
        if (wr == 1) PG8_BAR;
    }
    PG8_WAIT_V(0);
    PG8_BAR;
#undef PG8_SA
#undef PG8_SB
#undef PG8_STAGE
#undef PG8_LDA
#undef PG8_LDB
#undef PG8_MMA2
#undef PG8_MMA8
#undef PG8_LDA_M
#undef PG8_H
#undef PG8_WAIT_V
#undef PG8_WAIT_L
#undef PG8_BAR
#undef PG8_SCHED
#undef PG8_GOFFS
}

struct StaticOrder {
    static constexpr bool GATHER = false; static constexpr bool FP8 = false;
    __device__ unsigned row_off(const Unit&, int) const { return 0u; }
    int nM, nN, nwg, G, c; const char* A; const char* Bt; size_t tA, tB;
    __device__ void init(const void* A_, const void* Bt_, int M, int N, int lda, int ldb, int G_, int c_) { nM = M / BM; nN = N / BM; nwg = nM * nN; G = G_; c = c_; A = (const char*)A_; Bt = (const char*)Bt_; tA = (size_t)BM * lda * 2; tB = (size_t)BM * ldb * 2; }
    __device__ bool next(int i, Unit& u) const {
        const long L = (long)i * G + c; if (L >= nwg) return false;
        int wgid = (int)L; { const int q = nwg / NXCD, r = nwg % NXCD, xcd = wgid % NXCD, off = wgid / NXCD; wgid = (xcd < r ? xcd * (q + 1) : r * (q + 1) + (xcd - r) * q) + off; }
        const int nig = WGM * nN, gid = wgid / nig, fm = gid * WGM, gsz = (nM - fm) < WGM ? (nM - fm) : WGM;
        u.pm = fm + ((wgid % nig) % gsz); u.pn = (wgid % nig) / gsz; u.A = A + (size_t)u.pm * tA; u.B0 = Bt + (size_t)u.pn * tB; u.fin = 1; return true;
    }
};

struct EpiBf16 {
    static constexpr bool PERM = true;
    bf16_t* O; int ldc; const float* oml;
    __device__ __forceinline__ void operator()(const f32x4 (&acc)[2][2][4][2], const Unit& u, int wr, int wc, int fr, int fq) const {
        const int row0 = u.pm * BM + wr * 64 + fr, col0 = u.pn * BM + wc * 32 + 8 * fq;
        const int mode = (u.pn == 2 || u.pn == 3 || u.pn >= 10) ? 1 : ((u.pn >= 4 && u.pn <= 7) ? 2 : 0);
#pragma unroll
        for (int ai = 0; ai < 2; ++ai)
#pragma unroll
            for (int m = 0; m < 4; ++m) { bf16_t* rowp = O + (size_t)(row0 + ai * HALF + m * 16) * ldc + col0;
#pragma unroll
                for (int bj = 0; bj < 2; ++bj) { f32x4 v0 = acc[ai][bj][m][0], v1 = acc[ai][bj][m][1];
                    if (mode == 1) {
#pragma unroll
                        for (int j = 0; j < 4; ++j) { v0[j] = v0[j] * __builtin_amdgcn_rcpf(1.f + __expf(-v0[j])); v1[j] = v1[j] * __builtin_amdgcn_rcpf(1.f + __expf(-v1[j])); } }
                    else if (mode == 2) { const float* om = oml + (col0 + bj * HALF - 1024); const f32x4 m0 = *(const f32x4*)om, m1 = *(const f32x4*)(om + 4);
#pragma unroll
                        for (int j = 0; j < 4; ++j) { v0[j] = m0[j] * __builtin_amdgcn_rcpf(1.f + __expf(v0[j])); v1[j] = m1[j] * __builtin_amdgcn_rcpf(1.f + __expf(v1[j])); } }
                    u32x4 w; w.x = cvt_pk_bf16(v0[0], v0[1]); w.y = cvt_pk_bf16(v0[2], v0[3]); w.z = cvt_pk_bf16(v1[0], v1[1]); w.w = cvt_pk_bf16(v1[2], v1[3]);
                    *(u32x4*)(rowp + bj * HALF) = w; } }
    }
};
struct EpiResid {
    static constexpr bool PERM = true;
    const bf16_t* base; const float* inv; bf16_t* out;
    __device__ __forceinline__ void operator()(const f32x4 (&acc)[2][2][4][2], const Unit& u, int wr, int wc, int fr, int fq) const {
        const int row0 = u.pm * BM + wr * 64 + fr, col0 = u.pn * BM + wc * 32 + 8 * fq;
        const bf16_t* __restrict__ bp = base; bf16_t* __restrict__ op = out;
        u32x4 bv[2][4][2]; float iv[2][4];
#pragma unroll
        for (int ai = 0; ai < 2; ++ai)
#pragma unroll
            for (int m = 0; m < 4; ++m) { const int row = row0 + ai * HALF + m * 16; const size_t off = (size_t)row * DM + col0; iv[ai][m] = inv[row];
#pragma unroll
                for (int bj = 0; bj < 2; ++bj) bv[ai][m][bj] = *(const u32x4*)(bp + off + bj * HALF); }
        asm volatile("" ::: "memory");
#pragma unroll
        for (int ai = 0; ai < 2; ++ai)
#pragma unroll
            for (int m = 0; m < 4; ++m) { const size_t off = (size_t)(row0 + ai * HALF + m * 16) * DM + col0; const float s_ = iv[ai][m];
#pragma unroll
                for (int bj = 0; bj < 2; ++bj) { const u32x4 b_ = bv[ai][m][bj];
                    const f32x4 h0 = (f32x4){bflo(b_.x), bfhi(b_.x), bflo(b_.y), bfhi(b_.y)} * s_ + acc[ai][bj][m][0], h1 = (f32x4){bflo(b_.z), bfhi(b_.z), bflo(b_.w), bfhi(b_.w)} * s_ + acc[ai][bj][m][1];
                    u32x4 w; w.x = cvt_pk_bf16(h0[0], h0[1]); w.y = cvt_pk_bf16(h0[2], h0[3]); w.z = cvt_pk_bf16(h1[0], h1[1]); w.w = cvt_pk_bf16(h1[2], h1[3]);
                    *(u32x4*)(op + off + bj * HALF) = w; } }
    }
};
}

__device__ __forceinline__ void transpose_item(const float* W, int N, int k0, int n0, bf16_t* dst, int dst_ld, int drow0, const float* scale, float* scr, int lane) {
#pragma unroll
  for (int i = 0; i < 32; ++i) { const int kk = 2 * i + (lane >> 5); float v = W[(size_t)(k0 + kk) * N + n0 + (lane & 31)]; if (scale) v *= scale[k0 + kk]; scr[kk * 33 + (lane & 31)] = v; }
  LDS_WAIT();
  const int c = lane & 7;
#pragma unroll
  for (int j = 0; j < 4; ++j) { const int n = (lane >> 3) + 8 * j; const float* s = scr + (8 * c) * 33 + n;
    u32x4 o; o.x = cvt_pk_bf16(s[0 * 33], s[1 * 33]); o.y = cvt_pk_bf16(s[2 * 33], s[3 * 33]); o.z = cvt_pk_bf16(s[4 * 33], s[5 * 33]); o.w = cvt_pk_bf16(s[6 * 33], s[7 * 33]);
    *(u32x4*)(dst + (size_t)(drow0 + n) * dst_ld + k0 + 8 * c) = o; }
  LDS_WAIT();
}

__device__ __forceinline__ void transpose_item_fp8(const float* W, int N, int k0, int n0, unsigned char* dst, int dst_ld, int drow0, float sc, float* scr, int lane) {
#pragma unroll 8
  for (int i = 0; i < 32; ++i) { const int kk = 2 * i + (lane >> 5); scr[kk * 33 + (lane & 31)] = W[(size_t)(k0 + kk) * N + n0 + (lane & 31)] * sc; }
  LDS_WAIT();
  const int c = lane & 7;
#pragma unroll
  for (int j = 0; j < 4; ++j) { const int n = (lane >> 3) + 8 * j; const float* s = scr + (8 * c) * 33 + n;
    u32x2 o; o.x = pk4_fp8(s[0 * 33], s[1 * 33], s[2 * 33], s[3 * 33]); o.y = pk4_fp8(s[4 * 33], s[5 * 33], s[6 * 33], s[7 * 33]);
    *(u32x2*)(dst + (size_t)(drow0 + n) * dst_ld + k0 + 8 * c) = o; }
  LDS_WAIT();
}

__device__ __forceinline__ void phase_prep(const Params& p, char* lds) {
  const int tid = otid(), lane = tid & 63, wave = tid >> 6;
  const int gw = blockIdx.x * 8 + wave, NGW = gridDim.x * 8;
  unsigned char* ws = p.ws;
  float* scr = (float*)(lds + wave * 8704);
  constexpr int I_IN = 16 * 93, I_UQ = 4 * 24, I_UKV = 2 * 32, I_OUT = 16 * 32, I_G = 32 * 16 * 8, I_D = 32 * 4 * 32;
  constexpr int NITEMS = I_IN + I_UQ + I_UKV + I_OUT + 2 * I_G + I_D;
  for (int it = gw; it < NITEMS; it += NGW) {
    int r = it;
    if (r < I_IN) { const int kb = r / 93, nb = r % 93, n0 = nb * 32; transpose_item(p.w_in, N_IN, kb * 64, n0, (bf16_t*)(ws + WS_WIN), DM, n0 < 416 ? n0 : n0 + 96, p.norm_mix, scr, lane); continue; } r -= I_IN;
    if (r < I_UQ) { const int kb = r / 24, nb = r % 24; transpose_item(p.w_uq, 768, kb * 64, nb * 32, (bf16_t*)(ws + WS_WUQ), QLORA, nb * 32, p.q_lat_norm, scr, lane); continue; } r -= I_UQ;
    if (r < I_UKV) { const int kb = r / 32, nb = r % 32; transpose_item(p.w_ukv, 1024, kb * 64, nb * 32, (bf16_t*)(ws + WS_WUKV), KVLORA, nb * 32, p.kv_lat_norm, scr, lane); continue; } r -= I_UKV;
    if (r < I_OUT) { const int kb = r / 32, nb = r % 32; transpose_item(p.w_out, DM, kb * 64, nb * 32, (bf16_t*)(ws + WS_WOUT), DM, nb * 32, nullptr, scr, lane); continue; } r -= I_OUT;
    if (r < 2 * I_G) { const int up = r / I_G; r %= I_G; const int e = r / 128, q = r % 128, kb = q / 8, nb = q % 8, n0 = nb * 32;
      transpose_item_fp8((up ? p.w_up : p.w_gate) + (size_t)e * DM * DEXP, DEXP, kb * 64, n0, (unsigned char*)(ws + WS_WGU) + (size_t)e * 512 * DM, DM, (n0 >> 7) * 256 + up * 128 + (n0 & 127), WGU_SCALE, scr, lane); continue; } r -= 2 * I_G;
    { const int e = r / 128, q = r % 128, kb = q / 32, nb = q % 32; transpose_item_fp8(p.w_down + (size_t)e * DEXP * DM, DM, kb * 64, nb * 32, (unsigned char*)(ws + WS_WD) + (size_t)e * DM * DEXP, DEXP, nb * 32, WD_SCALE, scr, lane); }
  }
  for (int i = blockIdx.x * 512 + tid; i < 96 * 1024 / 8; i += gridDim.x * 512) ((u32x4*)(ws + WS_WIN + (size_t)416 * DM * 2))[i] = (u32x4){0u, 0u, 0u, 0u};
  for (int i = blockIdx.x * 512 + tid; i < 1024; i += gridDim.x * 512) ((float*)(ws + WS_OML))[i] = 1.f - 1.f / (1.f + __expf(p.lb_logits[1024 + i] - p.lb_logits[i]));
  for (int i = blockIdx.x * 512 + tid; i < SEQ * 16; i += gridDim.x * 512) {
    const int pos = i >> 4, j = i & 15;
    const float inv = 1.0f / powf(10000.0f, (float)j / 16.0f);
    const float ang = (float)pos * inv;
    double rev = (double)ang * 0.15915494309189535; rev -= __builtin_floor(rev);
    const float fr = (float)rev;
    ((float*)(ws + WS_ROPE))[i] = __builtin_amdgcn_cosf(fr);
    ((float*)(ws + WS_ROPE))[SEQ * 16 + i] = __builtin_amdgcn_sinf(fr);
  }
  for (int i = blockIdx.x * 512 + tid; i < 64 * DM; i += gridDim.x * 512) { const int c = i >> 10, k = i & 1023;
    const float w = c < 32 ? p.w_router[k * 32 + c] : (c < 36 ? p.w_group[k * 4 + (c - 32)] : 0.f);
    const unsigned short wh = f2bf(w); const unsigned short wl = f2bf(w - bf2f(wh));
    ((bf16_t*)(ws + WS_WR))[i] = wh; ((bf16_t*)(ws + WS_WR))[64 * DM + i] = wl; }
  bf16_t* XN = (bf16_t*)(ws + WS_R1);
  for (int m0 = gw; m0 < T; m0 += 4 * NGW) {
    f32x4 v[4][4];
#pragma unroll
    for (int q = 0; q < 4; ++q) { const int m = m0 + q * NGW; const f32x4* xr = (const f32x4*)(p.x + (size_t)(m < T ? m : m0) * DM) + lane;
#pragma unroll
      for (int j = 0; j < 4; ++j) v[q][j] = __builtin_nontemporal_load(&xr[64 * j]); }
#pragma unroll
    for (int q = 0; q < 4; ++q) { const int m = m0 + q * NGW; if (m >= T) break;
      float s = 0.f;
#pragma unroll
      for (int j = 0; j < 4; ++j) s += (v[q][j].x * v[q][j].x + v[q][j].y * v[q][j].y) + (v[q][j].z * v[q][j].z + v[q][j].w * v[q][j].w);
      const float ms_ = wave_sum(s) * (1.f / DM) + EPS; const float rs = rsqrtf(ms_);
      if (lane == 0) ((float*)(ws + WS_LIST))[m] = __builtin_sqrtf(ms_);
      u32x2* o8 = (u32x2*)(XN + (size_t)m * DM) + lane;
#pragma unroll
      for (int j = 0; j < 4; ++j) { u32x2 w; w.x = cvt_pk_bf16(v[q][j].x * rs, v[q][j].y * rs); w.y = cvt_pk_bf16(v[q][j].z * rs, v[q][j].w * rs); o8[64 * j] = w; } }
  }
}

template <int OFF> __device__ __forceinline__ s16x4 tr_read_g(int vb) {
  s16x4 r; asm volatile("ds_read_b64_tr_b16 %0, %1 offset:%2" : "=&v"(r) : "v"(vb), "i"(OFF) : "memory"); return r;
}
template <int KS, int HF> __device__ __forceinline__ void pv_gen(f32x16& od, int vb, bf16x8 pa0, bf16x8 pa1, bf16x8 pa2, bf16x8 pa3) {
  const s16x4 l0 = tr_read_g<0>(vb), h0 = tr_read_g<HF>(vb), l1 = tr_read_g<KS>(vb), h1 = tr_read_g<KS + HF>(vb);
  const s16x4 l2 = tr_read_g<2 * KS>(vb), h2 = tr_read_g<2 * KS + HF>(vb), l3 = tr_read_g<3 * KS>(vb), h3 = tr_read_g<3 * KS + HF>(vb);
  asm volatile("s_waitcnt lgkmcnt(0)" ::: "memory"); SBAR();
#define PK(L, H) (bf16x8){L[0], L[1], L[2], L[3], H[0], H[1], H[2], H[3]}
  od = __builtin_amdgcn_mfma_f32_32x32x16_bf16(pa0, PK(l0, h0), od, 0, 0, 0);
  od = __builtin_amdgcn_mfma_f32_32x32x16_bf16(pa1, PK(l1, h1), od, 0, 0, 0);
  od = __builtin_amdgcn_mfma_f32_32x32x16_bf16(pa2, PK(l2, h2), od, 0, 0, 0);
  od = __builtin_amdgcn_mfma_f32_32x32x16_bf16(pa3, PK(l3, h3), od, 0, 0, 0);
#undef PK
}
__device__ __forceinline__ int v_rd_base_g(int lane) { return ((lane & 3) << 3) | (((lane >> 2) & 3) << 6) | (((lane >> 4) & 1) << 5) | (((lane >> 5) & 1) << 8); }

__device__ __forceinline__ void phase_mla_prep(const Params& p, char* lds) {
  constexpr int PWQ = 528, PWK = 272, O_W = 0, O_G = 53248;
  const int tid = otid(), lane = tid & 63, wave = __builtin_amdgcn_readfirstlane(tid >> 6), r32 = lane & 31, hi = lane >> 5;
#define MP_DMA16(gbase, voff, laddr) asm volatile("s_mov_b32 m0, %0\n\ts_nop 0\n\tglobal_load_lds_dwordx4 %1, %2" :: "s"(laddr), "v"(voff), "s"(gbase) : "memory", "m0")
  const unsigned W_dma = (unsigned)(size_t)((LAS char*)lds) + O_W + wave * 1024;
  unsigned char* ws = p.ws;
  const bf16_t* proj = (const bf16_t*)(ws + WS_R2);
  const bf16_t* WUQ = (const bf16_t*)(ws + WS_WUQ);
  const bf16_t* WUKV = (const bf16_t*)(ws + WS_WUKV);
  const float* RC = (const float*)(ws + WS_ROPE); const float* RS = RC + SEQ * 16;
  unsigned char* Q8 = (unsigned char*)(ws + WS_R3); unsigned char* K8 = Q8 + (size_t)T * NH * 128; unsigned char* V8T = K8 + (size_t)T * NH * 128;
  constexpr int O_STG = 57344; char* stg = lds + O_STG + wave * 4096;
  const int tokl0 = lane >> 3, gph = lane & 7;
  float* gq = (float*)(lds + O_G); float* gk = gq + 96;
  if (tid < 96) { gq[tid] = p.q_norm[tid]; gk[tid] = p.k_norm[tid]; }
  for (int tile = blockIdx.x; tile < T / 256; tile += gridDim.x) {
    const int tok = tile * 256 + wave * 32 + r32, b = tok / SEQ, s = tok % SEQ;
    const bf16_t* prow = proj + (size_t)tok * NP;
    {
      bf16x8 bq[16]; float ssq = 0.f;
#pragma unroll
      for (int ks = 0; ks < 16; ++ks) { bq[ks] = *(const bf16x8*)(prow + ks * 16 + hi * 8);
#pragma unroll
        for (int j = 0; j < 8; ++j) { const float v = bf2f((unsigned short)bq[ks][j]); ssq += v * v; } }
      const float rq = rsqrtf((ssq + __shfl_xor(ssq, 32)) * (1.f / QLORA) + EPS);
      float rc_[8], rs_[8];
#pragma unroll
      for (int r = 0; r < 8; ++r) { const int i = crow(r, hi); rc_[r] = RC[s * 16 + i]; rs_[r] = RS[s * 16 + i]; }
      unsigned vq[7];
#pragma unroll
      for (int i = 0; i < 7; ++i) { const int G = (i * 8 + wave) * 64 + lane, rw_ = G / 33, c_ = G % 33; vq[i] = (unsigned)(((rw_ < 96 ? rw_ : 95) * QLORA + (c_ < 32 ? c_ * 8 : 0)) * 2); }
#define MP_QDMA(head) do { const char* wb_ = (const char*)(WUQ + (size_t)(head) * 96 * QLORA); _Pragma("unroll") for (int i = 0; i < 7; ++i) if (i * 8 + wave < 50) MP_DMA16(wb_, vq[i], W_dma + i * 8192); } while (0)
      __syncthreads();
      MP_QDMA(0);
      for (int head_ = 0; head_ < NH; ++head_) {
        int head = head_; asm volatile("" : "+s"(head));
        asm volatile("s_waitcnt vmcnt(0)" ::: "memory");
        __syncthreads();
        f32x16 acc[3];
#pragma unroll
        for (int nb = 0; nb < 3; ++nb) acc[nb] = f32x16{};
#pragma unroll
        for (int ks = 0; ks < 16; ++ks) {
#pragma unroll
          for (int nb = 0; nb < 3; ++nb) { const bf16x8 a = *(const bf16x8*)(lds + O_W + (nb * 32 + r32) * PWQ + (ks * 16 + hi * 8) * 2);
            acc[nb] = __builtin_amdgcn_mfma_f32_32x32x16_bf16(a, bq[ks], acc[nb], 0, 0, 0); }
          if (ks & 1) SBAR(); }
        __syncthreads();
        if (head + 1 < NH) MP_QDMA(head + 1);
        float ss = 0.f;
#pragma unroll
        for (int nb = 0; nb < 3; ++nb)
#pragma unroll
          for (int r = 0; r < 16; ++r) { const float u = acc[nb][r] * rq; acc[nb][r] = u; ss += u * u; }
        ss += __shfl_xor(ss, 32);
        const float rn = rsqrtf(ss * (1.f / DQK) + EPS) * QS2;
#pragma unroll
        for (int nb = 0; nb < 3; ++nb)
#pragma unroll
          for (int g = 0; g < 4; ++g) { const f32x4 gv = *(const f32x4*)(gq + nb * 32 + 8 * g + 4 * hi);
#pragma unroll
            for (int j = 0; j < 4; ++j) acc[nb][4 * g + j] *= rn * gv[j]; }
#pragma unroll
        for (int r = 0; r < 8; ++r) { const float c = rc_[r], sn = rs_[r];
          const float x1 = acc[2][r], x2 = acc[2][r + 8]; acc[2][r] = x1 * c - x2 * sn; acc[2][r + 8] = x2 * c + x1 * sn; }
        { const u32x6 f0 = cvt32_fp6(acc[0], acc[1]), f1 = cvt32_fp6(acc[2], f32x16{});
          char* srow = stg + r32 * 128; const int sw_ = r32 & 7;
          *(u32x4*)(srow + (((2 * hi) ^ sw_) * 16)) = (u32x4){f0[0], f0[1], f0[2], f0[3]}; *(u32x4*)(srow + (((2 * hi + 1) ^ sw_) * 16)) = (u32x4){f0[4], f0[5], 0u, 0u};
          *(u32x4*)(srow + (((4 + 2 * hi) ^ sw_) * 16)) = (u32x4){f1[0], f1[1], f1[2], f1[3]}; *(u32x4*)(srow + (((5 + 2 * hi) ^ sw_) * 16)) = (u32x4){f1[4], f1[5], 0u, 0u}; }
        { unsigned char* qblk = Q8 + ((size_t)(b * NH + head) * SEQ + (s - r32)) * 128;
#pragma unroll
          for (int i = 0; i < 4; ++i) { const int tl = 8 * i + tokl0; const u32x4 v = *(const u32x4*)(stg + tl * 128 + gph * 16);
            *(u32x4*)(qblk + tl * 128 + ((gph ^ (tl & 7)) * 16)) = v; } }
      }
    }
    asm volatile("" ::: "memory");
    {
      bf16x8 bk[8]; float ssk = 0.f;
#pragma unroll
      for (int ks = 0; ks < 8; ++ks) { bk[ks] = *(const bf16x8*)(prow + C_KVL + ks * 16 + hi * 8);
#pragma unroll
        for (int j = 0; j < 8; ++j) { const float v = bf2f((unsigned short)bk[ks][j]); ssk += v * v; } }
      const float rkv = rsqrtf((ssk + __shfl_xor(ssk, 32)) * (1.f / KVLORA) + EPS);
      u32x2 krw[4]; float ssr = 0.f;
#pragma unroll
      for (int g = 0; g < 4; ++g) { krw[g] = *(const u32x2*)(prow + C_KR + 8 * g + 4 * hi);
        ssr += bflo(krw[g].x) * bflo(krw[g].x) + bfhi(krw[g].x) * bfhi(krw[g].x) + bflo(krw[g].y) * bflo(krw[g].y) + bfhi(krw[g].y) * bfhi(krw[g].y); }
      float rc_[8], rs_[8];
#pragma unroll
      for (int r = 0; r < 8; ++r) { const int i = crow(r, hi); rc_[r] = RC[s * 16 + i]; rs_[r] = RS[s * 16 + i]; }
      unsigned vk[5];
#pragma unroll
      for (int i = 0; i < 5; ++i) { const int G = (i * 8 + wave) * 64 + lane, rw_ = G / 17, c_ = G % 17; vk[i] = (unsigned)(((rw_ < 128 ? rw_ : 127) * KVLORA + (c_ < 16 ? c_ * 8 : 0)) * 2); }
#define MP_KDMA(head) do { const char* wb_ = (const char*)(WUKV + (size_t)(head) * 128 * KVLORA); _Pragma("unroll") for (int i = 0; i < 5; ++i) if (i * 8 + wave < 34) MP_DMA16(wb_, vk[i], W_dma + i * 8192); } while (0)
      __syncthreads();
      MP_KDMA(0);
      for (int head_ = 0; head_ < NH; ++head_) {
        int head = head_; asm volatile("" : "+s"(head));
        asm volatile("s_waitcnt vmcnt(0)" ::: "memory");
        __syncthreads();
        f32x16 acc[4];
#pragma unroll
        for (int nb = 0; nb < 4; ++nb) acc[nb] = f32x16{};
#pragma unroll
        for (int ks = 0; ks < 8; ++ks) {
#pragma unroll
          for (int nb = 0; nb < 4; ++nb) { const bf16x8 a = *(const bf16x8*)(lds + O_W + (nb * 32 + r32) * PWK + (ks * 16 + hi * 8) * 2);
            acc[nb] = __builtin_amdgcn_mfma_f32_32x32x16_bf16(a, bk[ks], acc[nb], 0, 0, 0); }
          if (ks & 1) SBAR(); }
        __syncthreads();
        if (head + 1 < NH) MP_KDMA(head + 1);
        float ss = ssr;
#pragma unroll
        for (int nb = 0; nb < 4; ++nb)
#pragma unroll
          for (int r = 0; r < 16; ++r) { const float u = acc[nb][r] * rkv; acc[nb][r] = u; if (nb < 2) ss += u * u; }
        ss += __shfl_xor(ss, 32);
        const float rn = rsqrtf(ss * (1.f / DQK) + EPS) * QS2;
#pragma unroll
        for (int nb = 0; nb < 2; ++nb)
#pragma unroll
          for (int g = 0; g < 4; ++g) { const f32x4 gv = *(const f32x4*)(gk + nb * 32 + 8 * g + 4 * hi);
#pragma unroll
            for (int j = 0; j < 4; ++j) acc[nb][4 * g + j] *= rn * gv[j]; }
        float kr[16];
#pragma unroll
        for (int g = 0; g < 4; ++g) { kr[4 * g] = bflo(krw[g].x); kr[4 * g + 1] = bfhi(krw[g].x); kr[4 * g + 2] = bflo(krw[g].y); kr[4 * g + 3] = bfhi(krw[g].y); }
#pragma unroll
        for (int g = 0; g < 4; ++g) { const f32x4 gv = *(const f32x4*)(gk + 64 + 8 * g + 4 * hi);
#pragma unroll
          for (int j = 0; j < 4; ++j) kr[4 * g + j] *= rn * gv[j]; }
#pragma unroll
        for (int r = 0; r < 8; ++r) { const float c = rc_[r], sn = rs_[r];
          const float x1 = kr[r], x2 = kr[r + 8]; kr[r] = x1 * c - x2 * sn; kr[r + 8] = x2 * c + x1 * sn; }
        unsigned char* krow = K8 + ((size_t)(b * NH + head) * SEQ + s) * 128;
        unsigned char* vcol = V8T + (size_t)(b * NH + head) * DVH * SEQ + ((s & ~63) | ((s & 4) << 3) | ((s & 32) >> 1) | ((s & 16) >> 1) | ((s & 8) >> 1) | (s & 3));
        { f32x16 krv;
#pragma unroll
          for (int r = 0; r < 16; ++r) krv[r] = kr[r];
          const u32x6 f0 = cvt32_fp6(acc[0], acc[1]), f1 = cvt32_fp6(krv, f32x16{});
          char* srow = stg + r32 * 128; const int sw_ = r32 & 7;
          *(u32x4*)(srow + (((2 * hi) ^ sw_) * 16)) = (u32x4){f0[0], f0[1], f0[2], f0[3]}; *(u32x4*)(srow + (((2 * hi + 1) ^ sw_) * 16)) = (u32x4){f0[4], f0[5], 0u, 0u};
          *(u32x4*)(srow + (((4 + 2 * hi) ^ sw_) * 16)) = (u32x4){f1[0], f1[1], f1[2], f1[3]}; *(u32x4*)(srow + (((5 + 2 * hi) ^ sw_) * 16)) = (u32x4){f1[4], f1[5], 0u, 0u}; }
        { unsigned char* kblk = krow - (size_t)r32 * 128;
#pragma unroll
          for (int i = 0; i < 4; ++i) { const int tl = 8 * i + tokl0; const u32x4 v = *(const u32x4*)(stg + tl * 128 + gph * 16);
            *(u32x4*)(kblk + tl * 128 + ((gph ^ (tl & 7)) * 16)) = v; } }
#pragma unroll
        for (int nb = 2; nb < 4; ++nb)
#pragma unroll
          for (int r = 0; r < 16; r += 2) { const unsigned w = (unsigned)__builtin_amdgcn_cvt_pk_fp8_f32(__builtin_amdgcn_fmed3f(acc[nb][r], -448.f, 448.f), __builtin_amdgcn_fmed3f(acc[nb][r + 1], -448.f, 448.f), 0, false);
            vcol[(size_t)((nb - 2) * 32 + crow(r, hi)) * SEQ] = (unsigned char)(w & 0xffu); vcol[(size_t)((nb - 2) * 32 + crow(r + 1, hi)) * SEQ] = (unsigned char)((w >> 8) & 0xffu); }
      }
    }
    __syncthreads();
  }
}

namespace hg {
constexpr int PQ = 272, PS = 144;
constexpr int O_QD = 0, O_KD = O_QD + 64 * PQ, O_KTR = O_KD + 64 * PQ, O_V = O_KTR + 128 * PS, O_EV = O_V + 4096, BUF = O_EV + 1024;
constexpr int O_ST = 2 * BUF, O_OI = O_ST + 32 * PQ, O_TOT = O_OI + 2 * 32 * 144, O_FLAG = O_TOT + 4096, O_END = O_FLAG + 64;
__device__ __forceinline__ int v_st1(int k, int c) { const int kk = (k & ~0xC) | ((k & 4) << 1) | ((k & 8) >> 1); return (kk >> 3) * 512 + ((kk & 7) * 32 + c) * 2; }
}
__device__ __forceinline__ void phase_hgrn_fused(const Params& p, char* lds) {
  using namespace hg;
  const int tid = otid(), lane = tid & 63, dp = tid & 63, te = tid >> 6, r32 = lane & 31, hi = lane >> 5;
  const int wave = __builtin_amdgcn_readfirstlane(tid >> 6);
  unsigned char* ws = p.ws;
  const bf16_t* proj = (const bf16_t*)(ws + WS_R2);
  bf16_t* OFB = (bf16_t*)p.out;
  float* tot = (float*)(lds + O_TOT);
  unsigned* flag = (unsigned*)(lds + O_FLAG);
#define HGF_PK4(P, BASE, OUT) do { unsigned a0_ = cvt_pk_bf16(P[BASE + 0], P[BASE + 1]), a1_ = cvt_pk_bf16(P[BASE + 2], P[BASE + 3]);   \
    unsigned b0_ = cvt_pk_bf16(P[BASE + 4], P[BASE + 5]), b1_ = cvt_pk_bf16(P[BASE + 6], P[BASE + 7]);                              \
    auto r0_ = __builtin_amdgcn_permlane32_swap(a0_, b0_, false, false); auto r1_ = __builtin_amdgcn_permlane32_swap(a1_, b1_, false, false); \
    u32x4 w_ = {r0_[0], r1_[0], r0_[1], r1_[1]}; OUT = *reinterpret_cast<bf16x8*>(&w_); } while (0)
#define HGF_PK(L, H) (bf16x8){L[0], L[1], L[2], L[3], H[0], H[1], H[2], H[3]}
  for (int unit = blockIdx.x; unit < 2 * BATCH * HGH * 4; unit += gridDim.x) {
    const int sl = (unit >> 3) & 3, g8 = (unit & 7) | ((unit >> 5) << 3);
    const int h = g8 & 3, b = (g8 >> 2) & 7, dir = g8 >> 5;
    const int d0 = 2 * dp;
    const bf16_t* pbase = proj + (size_t)b * SEQ * NP + h * 128;
    const int cfz = dir ? C_FB : C_FF;
    f32x16 S = f32x16{};
    struct RawRegs { unsigned rq[8], rz[8]; bf16x8 rv; };
    RawRegs RA, RB;
#define HGF_LOAD(R, c) do { _Pragma("unroll") for (int i = 0; i < 8; ++i) { const int tt_ = (c) * 64 + 8 * te + i; const int tn_ = dir ? (SEQ - 1 - tt_) : tt_; \
      const bf16_t* pr_ = pbase + (size_t)tn_ * NP + d0; R.rq[i] = *(const unsigned*)(pr_ + C_HQ); R.rz[i] = *(const unsigned*)(pr_ + cfz); } \
    if (tid < 256) { const int tt_ = (c) * 64 + (tid >> 2); const int tn_ = dir ? (SEQ - 1 - tt_) : tt_; R.rv = *(const bf16x8*)(pbase + (size_t)tn_ * NP + C_HI + sl * 32 + (tid & 3) * 8); } } while (0)
    HGF_LOAD(RA, 0); HGF_LOAD(RB, 1);
    if (tid < 3) flag[tid] = 0u;
      {
      if (0 < NCHUNK) {
        float t0_ = 1.f, t1_ = 1.f;
#pragma unroll
        for (int i = 0; i < 8; ++i) { t0_ *= 1.f - bflo(RA.rz[i]); t1_ *= 1.f - bfhi(RA.rz[i]); }
        tot[te * 128 + d0] = t0_; tot[te * 128 + d0 + 1] = t1_;
      }
      __syncthreads();
      if (0 < NCHUNK) {
        char* img = lds + 0 * BUF;
        float qf[8][2], kk[8][2], ff[8][2], pp[8][2], sp[8][2];
#pragma unroll
        for (int i = 0; i < 8; ++i)
#pragma unroll
          for (int e = 0; e < 2; ++e) { qf[i][e] = e ? bfhi(RA.rq[i]) : bflo(RA.rq[i]); kk[i][e] = e ? bfhi(RA.rz[i]) : bflo(RA.rz[i]); ff[i][e] = 1.f - kk[i][e]; }
        const bf16x8 vcur = RA.rv;
        float off[2], pref[2], ptot[2];
#pragma unroll
        for (int e = 0; e < 2; ++e) { float o_ = 1.f, r_ = 1.f, t_ = 1.f;
#pragma unroll
          for (int j = 0; j < 8; ++j) { const float a = tot[j * 128 + d0 + e]; t_ *= a; if (j < te) o_ *= a; if (j < 4) r_ *= a; }
          off[e] = o_; pref[e] = r_; ptot[e] = t_; }
        const float ipr0 = __builtin_amdgcn_rcpf(pref[0]), ipr1 = __builtin_amdgcn_rcpf(pref[1]);
#pragma unroll
        for (int e = 0; e < 2; ++e) { pp[0][e] = ff[0][e] * (off[e] * (e ? ipr1 : ipr0));
#pragma unroll
          for (int i = 1; i < 8; ++i) pp[i][e] = pp[i - 1][e] * ff[i][e];
          sp[7][e] = __builtin_amdgcn_rcpf(pp[7][e]);
#pragma unroll
          for (int i = 6; i >= 0; --i) sp[i][e] = sp[i + 1][e] * ff[i + 1][e]; }
        unsigned wks[8];
#pragma unroll
        for (int i = 0; i < 8; ++i) { const int tl = 8 * te + i;
          const unsigned wq = cvt_pk_bf16(qf[i][0] * pp[i][0], qf[i][1] * pp[i][1]);
          const unsigned wk = cvt_pk_bf16(kk[i][0] * sp[i][0], kk[i][1] * sp[i][1]);
          *(unsigned*)(img + O_QD + tl * PQ + d0 * 2) = wq; *(unsigned*)(img + O_KD + tl * PQ + d0 * 2) = wk; wks[i] = wk; }
#pragma unroll
        for (int e = 0; e < 2; ++e) { u32x4 w_;
#pragma unroll
          for (int j = 0; j < 4; ++j) { const unsigned a_ = e ? (wks[2 * j] >> 16) : (wks[2 * j] & 0xffffu), b_ = e ? (wks[2 * j + 1] >> 16) : (wks[2 * j + 1] & 0xffffu); w_[j] = a_ | (b_ << 16); }
          *(u32x4*)(img + O_KTR + (d0 + e) * PS + te * 16) = w_; }
        float* evw = (float*)(img + O_EV);
        if (te == 0) { evw[d0] = pref[0]; evw[d0 + 1] = pref[1]; evw[128 + d0] = ptot[0] * ipr0; evw[128 + d0 + 1] = ptot[1] * ipr1; }
        if (tid < 256) *(bf16x8*)(img + O_V + v_st1(tid >> 2, (tid & 3) * 8)) = vcur;
        if (0 + 2 < NCHUNK) HGF_LOAD(RA, 0 + 2);
      }
      if (-1 >= 0) {
        const int c = -1; const char* img = lds + 1 * BUF; const float* evl = (const float*)(img + O_EV);
        const int vbV = (int)(uintptr_t)(img + O_V) + v_rd_base_g(lane);
        if (wave >= 4) {
          const int db = wave - 4;
          f32x16 Sp;
#pragma unroll
          for (int r = 0; r < 16; ++r) Sp[r] = S[r] * evl[db * 32 + crow(r, hi)];
#pragma unroll
          for (int g = 0; g < 4; ++g) { u32x2 w; w.x = cvt_pk_bf16(Sp[4 * g], Sp[4 * g + 1]); w.y = cvt_pk_bf16(Sp[4 * g + 2], Sp[4 * g + 3]);
            *(u32x2*)(lds + O_ST + r32 * PQ + (db * 32 + 8 * g + 4 * hi) * 2) = w; }
          asm volatile("s_waitcnt lgkmcnt(0)" ::: "memory");
          if (lane == 0) __hip_atomic_fetch_add(flag, 1u, __ATOMIC_RELEASE, __HIP_MEMORY_SCOPE_WORKGROUP);
          bf16x8 ka[4];
#pragma unroll
          for (int ks = 0; ks < 4; ++ks) ka[ks] = *(const bf16x8*)(img + O_KTR + (db * 32 + r32) * PS + (ks * 16 + hi * 8) * 2);
          const s16x4 l0 = tr_read_g<0>(vbV), h0 = tr_read_g<512>(vbV), l1 = tr_read_g<1024>(vbV), h1 = tr_read_g<1536>(vbV);
          const s16x4 l2 = tr_read_g<2048>(vbV), h2 = tr_read_g<2560>(vbV), l3 = tr_read_g<3072>(vbV), h3 = tr_read_g<3584>(vbV);
          asm volatile("s_waitcnt lgkmcnt(0)" ::: "memory"); SBAR();
          Sp = __builtin_amdgcn_mfma_f32_32x32x16_bf16(ka[0], HGF_PK(l0, h0), Sp, 0, 0, 0);
          Sp = __builtin_amdgcn_mfma_f32_32x32x16_bf16(ka[1], HGF_PK(l1, h1), Sp, 0, 0, 0);
          Sp = __builtin_amdgcn_mfma_f32_32x32x16_bf16(ka[2], HGF_PK(l2, h2), Sp, 0, 0, 0);
          Sp = __builtin_amdgcn_mfma_f32_32x32x16_bf16(ka[3], HGF_PK(l3, h3), Sp, 0, 0, 0);
#pragma unroll
          for (int r = 0; r < 16; ++r) S[r] = Sp[r] * evl[128 + db * 32 + crow(r, hi)];
        } else if (wave < 2) {
          const int tb = wave;
          f32x16 o = f32x16{};
          f32x16 p0 = f32x16{}, p1 = f32x16{};
#pragma unroll
          for (int ks = 0; ks < 8; ++ks) { const int cb = (ks * 16 + hi * 8) * 2;
            const bf16x8 qv = *(const bf16x8*)(img + O_QD + (tb * 32 + r32) * PQ + cb);
            const bf16x8 a0 = *(const bf16x8*)(img + O_KD + r32 * PQ + cb);
            p0 = __builtin_amdgcn_mfma_f32_32x32x16_bf16(a0, qv, p0, 0, 0, 0);
            if (tb) { const bf16x8 a1 = *(const bf16x8*)(img + O_KD + (32 + r32) * PQ + cb); p1 = __builtin_amdgcn_mfma_f32_32x32x16_bf16(a1, qv, p1, 0, 0, 0); } }
          const int tq = tb * 32 + r32;
#pragma unroll
          for (int r = 0; r < 16; ++r) { const int s0 = crow(r, hi); p0[r] = (s0 <= tq) ? p0[r] : 0.f; p1[r] = (32 + s0 <= tq) ? p1[r] : 0.f; }
          bf16x8 pa0, pa1, pa2, pa3;
          HGF_PK4(p0, 0, pa0); HGF_PK4(p0, 8, pa1); HGF_PK4(p1, 0, pa2); HGF_PK4(p1, 8, pa3);
          pv_gen<1024, 512>(o, vbV, pa0, pa1, pa2, pa3);
          float* oi = (float*)(lds + O_OI) + tb * (32 * 36);
#pragma unroll
          for (int r = 0; r < 16; ++r) oi[crow(r, hi) * 36 + r32] = o[r];
          asm volatile("s_waitcnt lgkmcnt(0)" ::: "memory");
          if (lane == 0) __hip_atomic_fetch_add(flag + 1 + tb, 1u, __ATOMIC_RELEASE, __HIP_MEMORY_SCOPE_WORKGROUP);
        } else {
          const int tb = wave - 2;
          { const unsigned want = 4u * (unsigned)(c + 1); while (__hip_atomic_load(flag, __ATOMIC_ACQUIRE, __HIP_MEMORY_SCOPE_WORKGROUP) < want) __builtin_amdgcn_s_sleep(1); }
          f32x16 o = f32x16{};
#pragma unroll
          for (int ks = 0; ks < 8; ++ks) { const bf16x8 a = *(const bf16x8*)(lds + O_ST + r32 * PQ + (ks * 16 + hi * 8) * 2);
            const bf16x8 bb = *(const bf16x8*)(img + O_QD + (tb * 32 + r32) * PQ + (ks * 16 + hi * 8) * 2);
            o = __builtin_amdgcn_mfma_f32_32x32x16_bf16(a, bb, o, 0, 0, 0); }
          { const unsigned want = (unsigned)(c + 1); while (__hip_atomic_load(flag + 1 + tb, __ATOMIC_ACQUIRE, __HIP_MEMORY_SCOPE_WORKGROUP) < want) __builtin_amdgcn_s_sleep(1); }
          const float* oi = (const float*)(lds + O_OI) + tb * (32 * 36) + r32 * 36;
          u32x2 wv_[4];
#pragma unroll
          for (int g = 0; g < 4; ++g) { const f32x4 iv = *(const f32x4*)(oi + 8 * g + 4 * hi);
            wv_[g].x = cvt_pk_bf16(o[4 * g] + iv.x, o[4 * g + 1] + iv.y); wv_[g].y = cvt_pk_bf16(o[4 * g + 2] + iv.z, o[4 * g + 3] + iv.w); }
          char* ost_ = lds + O_OI + tb * (32 * 144);
#pragma unroll
          for (int g = 0; g < 4; ++g) *(u32x2*)(ost_ + r32 * 144 + g * 16 + hi * 8) = wv_[g];
#pragma unroll
          for (int i = 0; i < 2; ++i) { const int orw_ = 16 * i + (lane >> 2), ogr_ = lane & 3; const u32x4 ov_ = *(const u32x4*)(ost_ + orw_ * 144 + ogr_ * 16);
            const int tt = c * 64 + tb * 32 + orw_; const int tn = dir ? (SEQ - 1 - tt) : tt;
            *(u32x4*)(OFB + ((size_t)dir * T + (size_t)b * SEQ + tn) * 512 + h * 128 + sl * 32 + ogr_ * 8) = ov_; }
        }
      }
      __syncthreads();
      }
    for (int c2 = 0; c2 < NCHUNK; c2 += 2) {
      {
      if ((c2 + 1) < NCHUNK) {
        float t0_ = 1.f, t1_ = 1.f;
#pragma unroll
        for (int i = 0; i < 8; ++i) { t0_ *= 1.f - bflo(RB.rz[i]); t1_ *= 1.f - bfhi(RB.rz[i]); }
        tot[te * 128 + d0] = t0_; tot[te * 128 + d0 + 1] = t1_;
      }
      __syncthreads();
      if ((c2 + 1) < NCHUNK) {
        char* img = lds + 1 * BUF;
        float qf[8][2], kk[8][2], ff[8][2], pp[8][2], sp[8][2];
#pragma unroll
        for (int i = 0; i < 8; ++i)
#pragma unroll
          for (int e = 0; e < 2; ++e) { qf[i][e] = e ? bfhi(RB.rq[i]) : bflo(RB.rq[i]); kk[i][e] = e ? bfhi(RB.rz[i]) : bflo(RB.rz[i]); ff[i][e] = 1.f - kk[i][e]; }
        const bf16x8 vcur = RB.rv;
        float off[2], pref[2], ptot[2];
#pragma unroll
        for (int e = 0; e < 2; ++e) { float o_ = 1.f, r_ = 1.f, t_ = 1.f;
#pragma unroll
          for (int j = 0; j < 8; ++j) { const float a = tot[j * 128 + d0 + e]; t_ *= a; if (j < te) o_ *= a; if (j < 4) r_ *= a; }
          off[e] = o_; pref[e] = r_; ptot[e] = t_; }
        const float ipr0 = __builtin_amdgcn_rcpf(pref[0]), ipr1 = __builtin_amdgcn_rcpf(pref[1]);
#pragma unroll
        for (int e = 0; e < 2; ++e) { pp[0][e] = ff[0][e] * (off[e] * (e ? ipr1 : ipr0));
#pragma unroll
          for (int i = 1; i < 8; ++i) pp[i][e] = pp[i - 1][e] * ff[i][e];
          sp[7][e] = __builtin_amdgcn_rcpf(pp[7][e]);
#pragma unroll
          for (int i = 6; i >= 0; --i) sp[i][e] = sp[i + 1][e] * ff[i + 1][e]; }
        unsigned wks[8];
#pragma unroll
        for (int i = 0; i < 8; ++i) { const int tl = 8 * te + i;
          const unsigned wq = cvt_pk_bf16(qf[i][0] * pp[i][0], qf[i][1] * pp[i][1]);
          const unsigned wk = cvt_pk_bf16(kk[i][0] * sp[i][0], kk[i][1] * sp[i][1]);
          *(unsigned*)(img + O_QD + tl * PQ + d0 * 2) = wq; *(unsigned*)(img + O_KD + tl * PQ + d0 * 2) = wk; wks[i] = wk; }
#pragma unroll
        for (int e = 0; e < 2; ++e) { u32x4 w_;
#pragma unroll
          for (int j = 0; j < 4; ++j) { const unsigned a_ = e ? (wks[2 * j] >> 16) : (wks[2 * j] & 0xffffu), b_ = e ? (wks[2 * j + 1] >> 16) : (wks[2 * j + 1] & 0xffffu); w_[j] = a_ | (b_ << 16); }
          *(u32x4*)(img + O_KTR + (d0 + e) * PS + te * 16) = w_; }
        float* evw = (float*)(img + O_EV);
        if (te == 0) { evw[d0] = pref[0]; evw[d0 + 1] = pref[1]; evw[128 + d0] = ptot[0] * ipr0; evw[128 + d0 + 1] = ptot[1] * ipr1; }
        if (tid < 256) *(bf16x8*)(img + O_V + v_st1(tid >> 2, (tid & 3) * 8)) = vcur;
        if ((c2 + 1) + 2 < NCHUNK) HGF_LOAD(RB, (c2 + 1) + 2);
      }
      if (c2 >= 0) {
        const int c = c2; const char* img = lds + 0 * BUF; const float* evl = (const float*)(img + O_EV);
        const int vbV = (int)(uintptr_t)(img + O_V) + v_rd_base_g(lane);
        if (wave >= 4) {
          const int db = wave - 4;
          f32x16 Sp;
#pragma unroll
          for (int r = 0; r < 16; ++r) Sp[r] = S[r] * evl[db * 32 + crow(r, hi)];
#pragma unroll
          for (int g = 0; g < 4; ++g) { u32x2 w; w.x = cvt_pk_bf16(Sp[4 * g], Sp[4 * g + 1]); w.y = cvt_pk_bf16(Sp[4 * g + 2], Sp[4 * g + 3]);
            *(u32x2*)(lds + O_ST + r32 * PQ + (db * 32 + 8 * g + 4 * hi) * 2) = w; }
          asm volatile("s_waitcnt lgkmcnt(0)" ::: "memory");
          if (lane == 0) __hip_atomic_fetch_add(flag, 1u, __ATOMIC_RELEASE, __HIP_MEMORY_SCOPE_WORKGROUP);
          bf16x8 ka[4];
#pragma unroll
          for (int ks = 0; ks < 4; ++ks) ka[ks] = *(const bf16x8*)(img + O_KTR + (db * 32 + r32) * PS + (ks * 16 + hi * 8) * 2);
          const s16x4 l0 = tr_read_g<0>(vbV), h0 = tr_read_g<512>(vbV), l1 = tr_read_g<1024>(vbV), h1 = tr_read_g<1536>(vbV);
          const s16x4 l2 = tr_read_g<2048>(vbV), h2 = tr_read_g<2560>(vbV), l3 = tr_read_g<3072>(vbV), h3 = tr_read_g<3584>(vbV);
          asm volatile("s_waitcnt lgkmcnt(0)" ::: "memory"); SBAR();
          Sp = __builtin_amdgcn_mfma_f32_32x32x16_bf16(ka[0], HGF_PK(l0, h0), Sp, 0, 0, 0);
          Sp = __builtin_amdgcn_mfma_f32_32x32x16_bf16(ka[1], HGF_PK(l1, h1), Sp, 0, 0, 0);
          Sp = __builtin_amdgcn_mfma_f32_32x32x16_bf16(ka[2], HGF_PK(l2, h2), Sp, 0, 0, 0);
          Sp = __builtin_amdgcn_mfma_f32_32x32x16_bf16(ka[3], HGF_PK(l3, h3), Sp, 0, 0, 0);
#pragma unroll
          for (int r = 0; r < 16; ++r) S[r] = Sp[r] * evl[128 + db * 32 + crow(r, hi)];
        } else if (wave < 2) {
          const int tb = wave;
          f32x16 o = f32x16{};
          f32x16 p0 = f32x16{}, p1 = f32x16{};
#pragma unroll
          for (int ks = 0; ks < 8; ++ks) { const int cb = (ks * 16 + hi * 8) * 2;
            const bf16x8 qv = *(const bf16x8*)(img + O_QD + (tb * 32 + r32) * PQ + cb);
            const bf16x8 a0 = *(const bf16x8*)(img + O_KD + r32 * PQ + cb);
            p0 = __builtin_amdgcn_mfma_f32_32x32x16_bf16(a0, qv, p0, 0, 0, 0);
            if (tb) { const bf16x8 a1 = *(const bf16x8*)(img + O_KD + (32 + r32) * PQ + cb); p1 = __builtin_amdgcn_mfma_f32_32x32x16_bf16(a1, qv, p1, 0, 0, 0); } }
          const int tq = tb * 32 + r32;
#pragma unroll
          for (int r = 0; r < 16; ++r) { const int s0 = crow(r, hi); p0[r] = (s0 <= tq) ? p0[r] : 0.f; p1[r] = (32 + s0 <= tq) ? p1[r] : 0.f; }
          bf16x8 pa0, pa1, pa2, pa3;
          HGF_PK4(p0, 0, pa0); HGF_PK4(p0, 8, pa1); HGF_PK4(p1, 0, pa2); HGF_PK4(p1, 8, pa3);
          pv_gen<1024, 512>(o, vbV, pa0, pa1, pa2, pa3);
          float* oi = (float*)(lds + O_OI) + tb * (32 * 36);
#pragma unroll
          for (int r = 0; r < 16; ++r) oi[crow(r, hi) * 36 + r32] = o[r];
          asm volatile("s_waitcnt lgkmcnt(0)" ::: "memory");
          if (lane == 0) __hip_atomic_fetch_add(flag + 1 + tb, 1u, __ATOMIC_RELEASE, __HIP_MEMORY_SCOPE_WORKGROUP);
        } else {
          const int tb = wave - 2;
          { const unsigned want = 4u * (unsigned)(c + 1); while (__hip_atomic_load(flag, __ATOMIC_ACQUIRE, __HIP_MEMORY_SCOPE_WORKGROUP) < want) __builtin_amdgcn_s_sleep(1); }
          f32x16 o = f32x16{};
#pragma unroll
          for (int ks = 0; ks < 8; ++ks) { const bf16x8 a = *(const bf16x8*)(lds + O_ST + r32 * PQ + (ks * 16 + hi * 8) * 2);
            const bf16x8 bb = *(const bf16x8*)(img + O_QD + (tb * 32 + r32) * PQ + (ks * 16 + hi * 8) * 2);
            o = __builtin_amdgcn_mfma_f32_32x32x16_bf16(a, bb, o, 0, 0, 0); }
          { const unsigned want = (unsigned)(c + 1); while (__hip_atomic_load(flag + 1 + tb, __ATOMIC_ACQUIRE, __HIP_MEMORY_SCOPE_WORKGROUP) < want) __builtin_amdgcn_s_sleep(1); }
          const float* oi = (const float*)(lds + O_OI) + tb * (32 * 36) + r32 * 36;
          u32x2 wv_[4];
#pragma unroll
          for (int g = 0; g < 4; ++g) { const f32x4 iv = *(const f32x4*)(oi + 8 * g + 4 * hi);
            wv_[g].x = cvt_pk_bf16(o[4 * g] + iv.x, o[4 * g + 1] + iv.y); wv_[g].y = cvt_pk_bf16(o[4 * g + 2] + iv.z, o[4 * g + 3] + iv.w); }
          char* ost_ = lds + O_OI + tb * (32 * 144);
#pragma unroll
          for (int g = 0; g < 4; ++g) *(u32x2*)(ost_ + r32 * 144 + g * 16 + hi * 8) = wv_[g];
#pragma unroll
          for (int i = 0; i < 2; ++i) { const int orw_ = 16 * i + (lane >> 2), ogr_ = lane & 3; const u32x4 ov_ = *(const u32x4*)(ost_ + orw_ * 144 + ogr_ * 16);
            const int tt = c * 64 + tb * 32 + orw_; const int tn = dir ? (SEQ - 1 - tt) : tt;
            *(u32x4*)(OFB + ((size_t)dir * T + (size_t)b * SEQ + tn) * 512 + h * 128 + sl * 32 + ogr_ * 8) = ov_; }
        }
      }
      __syncthreads();
      }
      {
      if ((c2 + 2) < NCHUNK) {
        float t0_ = 1.f, t1_ = 1.f;
#pragma unroll
        for (int i = 0; i < 8; ++i) { t0_ *= 1.f - bflo(RA.rz[i]); t1_ *= 1.f - bfhi(RA.rz[i]); }
        tot[te * 128 + d0] = t0_; tot[te * 128 + d0 + 1] = t1_;
      }
      __syncthreads();
      if ((c2 + 2) < NCHUNK) {
        char* img = lds + 0 * BUF;
        float qf[8][2], kk[8][2], ff[8][2], pp[8][2], sp[8][2];
#pragma unroll
        for (int i = 0; i < 8; ++i)
#pragma unroll
          for (int e = 0; e < 2; ++e) { qf[i][e] = e ? bfhi(RA.rq[i]) : bflo(RA.rq[i]); kk[i][e] = e ? bfhi(RA.rz[i]) : bflo(RA.rz[i]); ff[i][e] = 1.f - kk[i][e]; }
        const bf16x8 vcur = RA.rv;
        float off[2], pref[2], ptot[2];
#pragma unroll
        for (int e = 0; e < 2; ++e) { float o_ = 1.f, r_ = 1.f, t_ = 1.f;
#pragma unroll
          for (int j = 0; j < 8; ++j) { const float a = tot[j * 128 + d0 + e]; t_ *= a; if (j < te) o_ *= a; if (j < 4) r_ *= a; }
          off[e] = o_; pref[e] = r_; ptot[e] = t_; }
        const float ipr0 = __builtin_amdgcn_rcpf(pref[0]), ipr1 = __builtin_amdgcn_rcpf(pref[1]);
#pragma unroll
        for (int e = 0; e < 2; ++e) { pp[0][e] = ff[0][e] * (off[e] * (e ? ipr1 : ipr0));
#pragma unroll
          for (int i = 1; i < 8; ++i) pp[i][e] = pp[i - 1][e] * ff[i][e];
          sp[7][e] = __builtin_amdgcn_rcpf(pp[7][e]);
#pragma unroll
          for (int i = 6; i >= 0; --i) sp[i][e] = sp[i + 1][e] * ff[i + 1][e]; }
        unsigned wks[8];
#pragma unroll
        for (int i = 0; i < 8; ++i) { const int tl = 8 * te + i;
          const unsigned wq = cvt_pk_bf16(qf[i][0] * pp[i][0], qf[i][1] * pp[i][1]);
          const unsigned wk = cvt_pk_bf16(kk[i][0] * sp[i][0], kk[i][1] * sp[i][1]);
          *(unsigned*)(img + O_QD + tl * PQ + d0 * 2) = wq; *(unsigned*)(img + O_KD + tl * PQ + d0 * 2) = wk; wks[i] = wk; }
#pragma unroll
        for (int e = 0; e < 2; ++e) { u32x4 w_;
#pragma unroll
          for (int j = 0; j < 4; ++j) { const unsigned a_ = e ? (wks[2 * j] >> 16) : (wks[2 * j] & 0xffffu), b_ = e ? (wks[2 * j + 1] >> 16) : (wks[2 * j + 1] & 0xffffu); w_[j] = a_ | (b_ << 16); }
          *(u32x4*)(img + O_KTR + (d0 + e) * PS + te * 16) = w_; }
        float* evw = (float*)(img + O_EV);
        if (te == 0) { evw[d0] = pref[0]; evw[d0 + 1] = pref[1]; evw[128 + d0] = ptot[0] * ipr0; evw[128 + d0 + 1] = ptot[1] * ipr1; }
        if (tid < 256) *(bf16x8*)(img + O_V + v_st1(tid >> 2, (tid & 3) * 8)) = vcur;
        if ((c2 + 2) + 2 < NCHUNK) HGF_LOAD(RA, (c2 + 2) + 2);
      }
      if ((c2 + 1) >= 0) {
        const int c = (c2 + 1); const char* img = lds + 1 * BUF; const float* evl = (const float*)(img + O_EV);
        const int vbV = (int)(uintptr_t)(img + O_V) + v_rd_base_g(lane);
        if (wave >= 4) {
          const int db = wave - 4;
          f32x16 Sp;
#pragma unroll
          for (int r = 0; r < 16; ++r) Sp[r] = S[r] * evl[db * 32 + crow(r, hi)];
#pragma unroll
          for (int g = 0; g < 4; ++g) { u32x2 w; w.x = cvt_pk_bf16(Sp[4 * g], Sp[4 * g + 1]); w.y = cvt_pk_bf16(Sp[4 * g + 2], Sp[4 * g + 3]);
            *(u32x2*)(lds + O_ST + r32 * PQ + (db * 32 + 8 * g + 4 * hi) * 2) = w; }
          asm volatile("s_waitcnt lgkmcnt(0)" ::: "memory");
          if (lane == 0) __hip_atomic_fetch_add(flag, 1u, __ATOMIC_RELEASE, __HIP_MEMORY_SCOPE_WORKGROUP);
          bf16x8 ka[4];
#pragma unroll
          for (int ks = 0; ks < 4; ++ks) ka[ks] = *(const bf16x8*)(img + O_KTR + (db * 32 + r32) * PS + (ks * 16 + hi * 8) * 2);
          const s16x4 l0 = tr_read_g<0>(vbV), h0 = tr_read_g<512>(vbV), l1 = tr_read_g<1024>(vbV), h1 = tr_read_g<1536>(vbV);
          const s16x4 l2 = tr_read_g<2048>(vbV), h2 = tr_read_g<2560>(vbV), l3 = tr_read_g<3072>(vbV), h3 = tr_read_g<3584>(vbV);
          asm volatile("s_waitcnt lgkmcnt(0)" ::: "memory"); SBAR();
          Sp = __builtin_amdgcn_mfma_f32_32x32x16_bf16(ka[0], HGF_PK(l0, h0), Sp, 0, 0, 0);
          Sp = __builtin_amdgcn_mfma_f32_32x32x16_bf16(ka[1], HGF_PK(l1, h1), Sp, 0, 0, 0);
          Sp = __builtin_amdgcn_mfma_f32_32x32x16_bf16(ka[2], HGF_PK(l2, h2), Sp, 0, 0, 0);
          Sp = __builtin_amdgcn_mfma_f32_32x32x16_bf16(ka[3], HGF_PK(l3, h3), Sp, 0, 0, 0);
#pragma unroll
          for (int r = 0; r < 16; ++r) S[r] = Sp[r] * evl[128 + db * 32 + crow(r, hi)];
        } else if (wave < 2) {
          const int tb = wave;
          f32x16 o = f32x16{};
          f32x16 p0 = f32x16{}, p1 = f32x16{};
#pragma unroll
          for (int ks = 0; ks < 8; ++ks) { const int cb = (ks * 16 + hi * 8) * 2;
            const bf16x8 qv = *(const bf16x8*)(img + O_QD + (tb * 32 + r32) * PQ + cb);
            const bf16x8 a0 = *(const bf16x8*)(img + O_KD + r32 * PQ + cb);
            p0 = __builtin_amdgcn_mfma_f32_32x32x16_bf16(a0, qv, p0, 0, 0, 0);
            if (tb) { const bf16x8 a1 = *(const bf16x8*)(img + O_KD + (32 + r32) * PQ + cb); p1 = __builtin_amdgcn_mfma_f32_32x32x16_bf16(a1, qv, p1, 0, 0, 0); } }
          const int tq = tb * 32 + r32;
#pragma unroll
          for (int r = 0; r < 16; ++r) { const int s0 = crow(r, hi); p0[r] = (s0 <= tq) ? p0[r] : 0.f; p1[r] = (32 + s0 <= tq) ? p1[r] : 0.f; }
          bf16x8 pa0, pa1, pa2, pa3;
          HGF_PK4(p0, 0, pa0); HGF_PK4(p0, 8, pa1); HGF_PK4(p1, 0, pa2); HGF_PK4(p1, 8, pa3);
          pv_gen<1024, 512>(o, vbV, pa0, pa1, pa2, pa3);
          float* oi = (float*)(lds + O_OI) + tb * (32 * 36);
#pragma unroll
          for (int r = 0; r < 16; ++r) oi[crow(r, hi) * 36 + r32] = o[r];
          asm volatile("s_waitcnt lgkmcnt(0)" ::: "memory");
          if (lane == 0) __hip_atomic_fetch_add(flag + 1 + tb, 1u, __ATOMIC_RELEASE, __HIP_MEMORY_SCOPE_WORKGROUP);
        } else {
          const int tb = wave - 2;
          { const unsigned want = 4u * (unsigned)(c + 1); while (__hip_atomic_load(flag, __ATOMIC_ACQUIRE, __HIP_MEMORY_SCOPE_WORKGROUP) < want) __builtin_amdgcn_s_sleep(1); }
          f32x16 o = f32x16{};
#pragma unroll
          for (int ks = 0; ks < 8; ++ks) { const bf16x8 a = *(const bf16x8*)(lds + O_ST + r32 * PQ + (ks * 16 + hi * 8) * 2);
            const bf16x8 bb = *(const bf16x8*)(img + O_QD + (tb * 32 + r32) * PQ + (ks * 16 + hi * 8) * 2);
            o = __builtin_amdgcn_mfma_f32_32x32x16_bf16(a, bb, o, 0, 0, 0); }
          { const unsigned want = (unsigned)(c + 1); while (__hip_atomic_load(flag + 1 + tb, __ATOMIC_ACQUIRE, __HIP_MEMORY_SCOPE_WORKGROUP) < want) __builtin_amdgcn_s_sleep(1); }
          const float* oi = (const float*)(lds + O_OI) + tb * (32 * 36) + r32 * 36;
          u32x2 wv_[4];
#pragma unroll
          for (int g = 0; g < 4; ++g) { const f32x4 iv = *(const f32x4*)(oi + 8 * g + 4 * hi);
            wv_[g].x = cvt_pk_bf16(o[4 * g] + iv.x, o[4 * g + 1] + iv.y); wv_[g].y = cvt_pk_bf16(o[4 * g + 2] + iv.z, o[4 * g + 3] + iv.w); }
          char* ost_ = lds + O_OI + tb * (32 * 144);
#pragma unroll
          for (int g = 0; g < 4; ++g) *(u32x2*)(ost_ + r32 * 144 + g * 16 + hi * 8) = wv_[g];
#pragma unroll
          for (int i = 0; i < 2; ++i) { const int orw_ = 16 * i + (lane >> 2), ogr_ = lane & 3; const u32x4 ov_ = *(const u32x4*)(ost_ + orw_ * 144 + ogr_ * 16);
            const int tt = c * 64 + tb * 32 + orw_; const int tn = dir ? (SEQ - 1 - tt) : tt;
            *(u32x4*)(OFB + ((size_t)dir * T + (size_t)b * SEQ + tn) * 512 + h * 128 + sl * 32 + ogr_ * 8) = ov_; }
        }
      }
      __syncthreads();
      }
    }
#undef HGF_LOAD
  }
#undef HGF_PK4
#undef HGF_PK
}

namespace att {
constexpr int NW = 8, KVBLK = 64;
constexpr int SHM_K = 64 * 128, SHM_V = 64 * 64;
constexpr int OFF_V = 0, OFF_K = 3 * SHM_V, SHM_ATTN = OFF_K + 2 * SHM_K;
#define ATT_MFMA(A, B, C, BFMT) __builtin_amdgcn_mfma_scale_f32_32x32x64_f8f6f4(A, B, C, 0, BFMT, 0, 0x7f7f7f7f, 0, 0x7f7f7f7f)
#define ATT_MFMA6(A, B, C) __builtin_amdgcn_mfma_scale_f32_32x32x64_f8f6f4(A, B, C, 2, 2, 0, 0x7d7d7d7d, 0, 0x7d7d7d7d)
__device__ __forceinline__ i32x8 ld32(const char* p0, const char* p1) { const u32x4 a = *reinterpret_cast<const u32x4*>(p0), b = *reinterpret_cast<const u32x4*>(p1);
  return (i32x8){(int)a.x, (int)a.y, (int)a.z, (int)a.w, (int)b.x, (int)b.y, (int)b.z, (int)b.w}; }
__device__ __forceinline__ i32x8 ld24(const char* p0, const char* p1) { const u32x4 a = *reinterpret_cast<const u32x4*>(p0); const u32x2 b = *reinterpret_cast<const u32x2*>(p1);
  return (i32x8){(int)a.x, (int)a.y, (int)a.z, (int)a.w, (int)b.x, (int)b.y, 0, 0}; }
__device__ __forceinline__ void qkt8(f32x16 (&p)[2][2], const char* Ks, const i32x8 (&qr)[2][2], unsigned kb_) {
#pragma unroll
  for (int ks = 0; ks < 2; ++ks)
#pragma unroll
    for (int kb = 0; kb < 2; ++kb) { const char* r0 = Ks + kb * 4096;
      const i32x8 a = ld24(r0 + (kb_ ^ (unsigned)(ks * 64)), r0 + (kb_ ^ (unsigned)(ks * 64 + 16)));
#pragma unroll
      for (int qb = 0; qb < 2; ++qb) p[qb][kb] = (ks == 0) ? ATT_MFMA6(a, qr[qb][0], f32x16{}) : ATT_MFMA6(a, qr[qb][1], p[qb][kb]); }
}
__device__ __forceinline__ void softmax8(f32x16 (&p)[2][2], i32x8 (&pb)[2]) {
#pragma unroll
  for (int qb = 0; qb < 2; ++qb) {
#pragma unroll
    for (int r = 0; r < 16; ++r) { p[qb][0][r] = __builtin_amdgcn_exp2f(p[qb][0][r]); p[qb][1][r] = __builtin_amdgcn_exp2f(p[qb][1][r]); }
#pragma unroll
    for (int v = 0; v < 8; ++v) { const int kb = v >> 2, r0 = 4 * (v & 3); pb[qb][v] = (int)pk4_bf8(p[qb][kb][r0], p[qb][kb][r0 + 1], p[qb][kb][r0 + 2], p[qb][kb][r0 + 3]); } }
}
__device__ __forceinline__ void pvt8(f32x16 (&o)[2][2], f32x16 (&lsum)[2], const char* Vs, const i32x8 (&pb)[2], unsigned vb_) {
  const i32x8 ones = (i32x8){0x38383838, 0x38383838, 0x38383838, 0x38383838, 0x38383838, 0x38383838, 0x38383838, 0x38383838};
#pragma unroll
  for (int dvb = 0; dvb < 2; ++dvb) { const char* r0 = Vs + dvb * 2048;
    const i32x8 a = ld32(r0 + vb_, r0 + (vb_ ^ 16u));
#pragma unroll
    for (int qb = 0; qb < 2; ++qb) o[qb][dvb] = ATT_MFMA(a, pb[qb], o[qb][dvb], 1); }
#pragma unroll
  for (int qb = 0; qb < 2; ++qb) lsum[qb] = ATT_MFMA(ones, pb[qb], lsum[qb], 1);
}

__device__ __forceinline__ void attn_unit(const unsigned char* __restrict__ Qb, const unsigned char* __restrict__ Kh, const unsigned char* __restrict__ VTh, bf16_t* __restrict__ Ob, char* lds) {
  const int tid = otid(), wid = __builtin_amdgcn_readfirstlane(tid >> 6), lane = tid & 63, r32 = lane & 31, hi = lane >> 5;
  char* V_lds = lds + OFF_V; char* K_lds = lds + OFF_K;
  f32x16 lsum[2] = {}; f32x16 o[2][2] = {}; i32x8 qr[2][2];
#pragma unroll
  for (int qb = 0; qb < 2; ++qb) { const char* Qw = (const char*)Qb + (unsigned)((wid * 64 + qb * 32 + r32) * 128 + hi * 32);
#pragma unroll
    for (int ks = 0; ks < 2; ++ks) qr[qb][ks] = ld24(Qw + ks * 64, Qw + ks * 64 + 16); }
  unsigned kgo, vgo, vb_, kb_;
  { const int kr = wid * 8 + (lane >> 3), kc = (lane & 7) ^ ((kr >> 1) & 7);
    kgo = kr * 128 + kc * 16;
    const int vr = (wid & 3) * 16 + (lane >> 2), vc = (lane & 3) ^ ((vr >> 2) & 3);
    vgo = vr * SEQ + vc * 16;
    kb_ = r32 * 128 + (((2 * hi) ^ ((r32 >> 1) & 7)) * 16);
    vb_ = r32 * 64 + (((2 * hi) ^ ((r32 >> 2) & 3)) * 16);
    asm volatile("" : "+v"(kgo), "+v"(vgo), "+v"(vb_), "+v"(kb_)); }
#define DMA16(gbase, voff, laddr) asm volatile("s_mov_b32 m0, %0\n\ts_nop 0\n\tglobal_load_lds_dwordx4 %1, %2" :: "s"(laddr), "v"(voff), "s"(gbase) : "memory", "m0")
  const unsigned K_dma = (unsigned)(size_t)((LAS char*)lds) + OFF_K + wid * 1024, V_dma = (unsigned)(size_t)((LAS char*)lds) + OFF_V + (wid & 3) * 1024;
#define KVDMA(k0, ko, vo) do { const char* kt_ = (const char*)Kh + (size_t)(k0) * 128; DMA16(kt_, kgo, K_dma + (ko)); \
    if (wid < 4) { const char* vt_ = (const char*)VTh + (size_t)(k0); DMA16(vt_, vgo, V_dma + (vo)); } } while (0)
  constexpr int NT = SEQ / KVBLK;
  KVDMA(0, 0, 0);
  asm volatile("s_waitcnt vmcnt(0)" ::: "memory"); __syncthreads();
  int ko = 0, va = 0, vn = SHM_V, vw = 2 * SHM_V;
  f32x16 p[2][2]; i32x8 pb[2];
  if (wid < 4) {
#pragma unroll 1
    for (int t = 0; t < NT; ++t) {
      { const int t1 = (t + 1 < NT ? t + 1 : NT - 1); KVDMA(t1 * KVBLK, ko ^ SHM_K, vn); }
      SBAR();
      qkt8(p, K_lds + ko, qr, kb_);
      softmax8(p, pb);
      pvt8(o, lsum, V_lds + va, pb, vb_);
      asm volatile("s_waitcnt vmcnt(0)" ::: "memory");
      __syncthreads();
      ko ^= SHM_K; { const int tmp = vw; vw = va; va = vn; vn = tmp; }
    }
  } else {
#pragma unroll 1
    for (int t = 0; t < NT; ++t) {
      { const int t1 = (t + 1 < NT ? t + 1 : NT - 1); KVDMA(t1 * KVBLK, ko ^ SHM_K, vn); }
      SBAR();
      if (t > 0) { softmax8(p, pb); pvt8(o, lsum, V_lds + vw, pb, vb_); }
      SBAR();
      qkt8(p, K_lds + ko, qr, kb_);
      asm volatile("s_waitcnt vmcnt(0)" ::: "memory");
      __syncthreads();
      ko ^= SHM_K; { const int tmp = vw; vw = va; va = vn; vn = tmp; }
    }
    softmax8(p, pb); pvt8(o, lsum, V_lds + vw, pb, vb_);
  }
  __syncthreads();
  { const int t2_ = otid(), l2_ = t2_ & 63, r32b = l2_ & 31, hib = l2_ >> 5;
    char* stg = lds + 32768 + wid * 8192;
#pragma unroll
    for (int qb = 0; qb < 2; ++qb) {
      const float rl = __builtin_amdgcn_rcpf(lsum[qb][0]);
      const int row = qb * 32 + r32b;
#pragma unroll
      for (int d0 = 0; d0 < 2; ++d0)
#pragma unroll
        for (int g = 0; g < 4; ++g) { u32x2 w; w.x = cvt_pk_bf16(o[qb][d0][4 * g] * rl, o[qb][d0][4 * g + 1] * rl); w.y = cvt_pk_bf16(o[qb][d0][4 * g + 2] * rl, o[qb][d0][4 * g + 3] * rl);
          *(u32x2*)(stg + row * 128 + (((d0 * 4 + g) ^ (row & 7)) * 16) + 8 * hib) = w; } }
    char* Ow = (char*)Ob + (unsigned)((wid * 64) * DM * 2);
#pragma unroll
    for (int i = 0; i < 8; ++i) { const int tl = 8 * i + (l2_ >> 3), gp = l2_ & 7; const u32x4 v = *(const u32x4*)(stg + tl * 128 + gp * 16);
      *(u32x4*)(Ow + (unsigned)(tl * DM * 2) + ((gp ^ (tl & 7)) * 16)) = v; } }
#undef DMA16
#undef KVDMA
}
}

__device__ __forceinline__ void phase_attention(const Params& p, char* lds, int u_) {
  unsigned char* ws = p.ws;
  const unsigned char* Q8 = (const unsigned char*)(ws + WS_R3); const unsigned char* K8 = Q8 + (size_t)T * NH * 128; const unsigned char* V8T = K8 + (size_t)T * NH * 128;
  bf16_t* mix = (bf16_t*)(ws + WS_R4);
  const int xcd = blockIdx.x & 7, j = blockIdx.x >> 3, nj = gridDim.x >> 3;
  (void)j; (void)nj;
  {
    int u = u_; asm volatile("" : "+s"(u));
    const int bh = xcd * 8 + (u >> 4), qb = u & 15, b = bh >> 3, h = bh & 7;
    att::attn_unit(Q8 + ((size_t)bh * SEQ + qb * 512) * 128, K8 + (size_t)bh * SEQ * 128, V8T + (size_t)bh * DVH * SEQ,
                   mix + ((size_t)b * SEQ + qb * 512) * DM + h * DVH, lds);
  }
}

__device__ __forceinline__ void phase_hgrn_final(const Params& p) {
  const int tid = otid(), lane = tid & 63, wave = tid >> 6;
  unsigned char* ws = p.ws;
  const bf16_t* proj = (const bf16_t*)(ws + WS_R2);
  const bf16_t* OFB = (const bf16_t*)p.out;
  bf16_t* mix = (bf16_t*)(ws + WS_R4);
  const int e0 = (lane & 15) * 8;
  float gn[8];
#pragma unroll
  for (int j = 0; j < 8; ++j) gn[j] = p.hg_out_norm[e0 + j];
  const int mstr = gridDim.x * 8;
  for (int m0 = blockIdx.x * 8 + wave; m0 < T; m0 += 8 * mstr) {
    u32x4 a4[8], b4[8], g4[8];
#pragma unroll
    for (int k = 0; k < 8; ++k) { const int mk = (m0 + k * mstr < T) ? m0 + k * mstr : m0;
      a4[k] = *(const u32x4*)(OFB + (size_t)mk * 512 + lane * 8); b4[k] = *(const u32x4*)(OFB + ((size_t)T + mk) * 512 + lane * 8); g4[k] = *(const u32x4*)(proj + (size_t)mk * NP + C_HG + lane * 8); }
    asm volatile("" ::: "memory");
#pragma unroll
    for (int k = 0; k < 8; ++k) { const int m = m0 + k * mstr; if (m < T) {
    const u32x4 a = a4[k], bq = b4[k], g = g4[k];
    float o[8], hgv[8];
#pragma unroll
    for (int j = 0; j < 4; ++j) { o[2 * j] = bflo(a[j]) + bflo(bq[j]); o[2 * j + 1] = bfhi(a[j]) + bfhi(bq[j]); hgv[2 * j] = bflo(g[j]); hgv[2 * j + 1] = bfhi(g[j]); }
    float ss = 0.f;
#pragma unroll
    for (int j = 0; j < 8; ++j) ss += o[j] * o[j];
    ss += __shfl_xor(ss, 1); ss += __shfl_xor(ss, 2); ss += __shfl_xor(ss, 4); ss += __shfl_xor(ss, 8);
    const float rn = rsqrtf(ss * (1.f / HDV) + EPS);
    u32x4 w;
#pragma unroll
    for (int j = 0; j < 4; ++j) { const float v0 = o[2 * j] * rn * gn[2 * j] * hgv[2 * j], v1 = o[2 * j + 1] * rn * gn[2 * j + 1] * hgv[2 * j + 1];
      w[j] = cvt_pk_bf16(v0, v1); }
    *(u32x4*)(mix + (size_t)m * DM + 512 + lane * 8) = w;
    } }
  }
}

__device__ __forceinline__ void phase_router(const Params& p, char* lds) {
  constexpr int RPW = 144, RHL = 64 * RPW, RBUF = 2 * RHL, O_G = 2 * RBUF;
  constexpr int HPW = 272, O_H = 45056;
  const int tid = otid(), lane = tid & 63, wave = tid >> 6, r32 = lane & 31, hi = lane >> 5;
  unsigned char* ws = p.ws;
  unsigned char* XN2 = (unsigned char*)(ws + WS_R1);
  const bf16_t* WRh = (const bf16_t*)(ws + WS_WR); const bf16_t* WRl = WRh + 64 * DM;
  unsigned* cnt = (unsigned*)(ws + WS_CNT);
  int* list = (int*)(ws + WS_LIST);
  float* gate = (float*)(ws + WS_GATE);
  float* gl_ = (float*)(lds + O_G);
  for (int i = tid; i < DM / 4; i += 512) ((f32x4*)gl_)[i] = ((const f32x4*)p.norm_ffn)[i];
  const int wrow = tid >> 3, wg = tid & 7;
  for (int tb = blockIdx.x; tb < T / 256; tb += gridDim.x) {
    const int tok = tb * 256 + wave * 32 + r32;
    char* xs_ = lds + 114688 + wave * 2560;
    f32x16 acc0 = f32x16{}, acc1 = f32x16{};
    float ss = 0.f;
    const bf16_t* hld = (const bf16_t*)(ws + WS_H16) + (size_t)(tb * 256 + wave * 32 + (lane >> 4)) * DM + (lane & 15) * 4;
    char* hw_ = lds + O_H + wave * (32 * HPW) + (lane >> 4) * HPW + (lane & 15) * 16;
    const char* hr_ = lds + O_H + wave * (32 * HPW) + r32 * HPW + hi * 32;
    u32x2 hq[2][8];
#define HQ_F32(q) (f32x4){bflo((q).x), bfhi((q).x), bflo((q).y), bfhi((q).y)}
#pragma unroll
    for (int i = 0; i < 8; ++i) { hq[0][i] = *(const u32x2*)(hld + (size_t)(4 * i) * DM); hq[1][i] = *(const u32x2*)(hld + (size_t)(4 * i) * DM + 64); }
#pragma unroll
    for (int i = 0; i < 8; ++i) *(f32x4*)(hw_ + 4 * i * HPW) = HQ_F32(hq[0][i]);
    bf16x8 wsh = *(const bf16x8*)(WRh + (size_t)wrow * DM + wg * 8), wsl = *(const bf16x8*)(WRl + (size_t)wrow * DM + wg * 8);
    __syncthreads();
    *(bf16x8*)(lds + wrow * RPW + wg * 16) = wsh; *(bf16x8*)(lds + RHL + wrow * RPW + wg * 16) = wsl;
    wsh = *(const bf16x8*)(WRh + (size_t)wrow * DM + 64 + wg * 8); wsl = *(const bf16x8*)(WRl + (size_t)wrow * DM + 64 + wg * 8);
    __syncthreads();
#pragma unroll 1
    for (int cp = 0; cp < 8; ++cp) {
#pragma unroll
      for (int half = 0; half < 2; ++half) {
        const int c = cp * 2 + half; const char* wb = lds + half * RBUF;
        { const int c2 = c + 2 < 16 ? c + 2 : 15;
#pragma unroll
          for (int i = 0; i < 8; ++i) hq[half][i] = *(const u32x2*)(hld + (size_t)(4 * i) * DM + c2 * 64); }
#pragma unroll
        for (int s4 = 0; s4 < 4; ++s4) { const int j = half * 4 + s4, ks = cp * 8 + j;
          const f32x4 h0 = *(const f32x4*)(hr_ + s4 * 64), h1 = *(const f32x4*)(hr_ + s4 * 64 + 16);
          const f32x4 g0 = *(const f32x4*)(gl_ + ks * 16 + hi * 8), g1 = *(const f32x4*)(gl_ + ks * 16 + hi * 8 + 4);
          ss += (h0.x * h0.x + h0.y * h0.y) + (h0.z * h0.z + h0.w * h0.w) + (h1.x * h1.x + h1.y * h1.y) + (h1.z * h1.z + h1.w * h1.w);
          const f32x4 y0 = h0 * g0, y1 = h1 * g1;
          u32x4 wh; wh.x = cvt_pk_bf16(y0.x, y0.y); wh.y = cvt_pk_bf16(y0.z, y0.w); wh.z = cvt_pk_bf16(y1.x, y1.y); wh.w = cvt_pk_bf16(y1.z, y1.w);
          u32x4 wl; wl.x = cvt_pk_bf16(y0.x - bflo(wh.x), y0.y - bfhi(wh.x)); wl.y = cvt_pk_bf16(y0.z - bflo(wh.y), y0.w - bfhi(wh.y));
          wl.z = cvt_pk_bf16(y1.x - bflo(wh.z), y1.y - bfhi(wh.z)); wl.w = cvt_pk_bf16(y1.z - bflo(wh.w), y1.w - bfhi(wh.w));
          { u32x2 w8; w8.x = pk4_fp8(y0.x, y0.y, y0.z, y0.w); w8.y = pk4_fp8(y1.x, y1.y, y1.z, y1.w); *(u32x2*)(xs_ + r32 * 80 + s4 * 16 + hi * 8) = w8; }
          const bf16x8 yh = *reinterpret_cast<bf16x8*>(&wh), yl = *reinterpret_cast<bf16x8*>(&wl);
          const char* wa = wb + r32 * RPW + (s4 * 16 + hi * 8) * 2;
          const bf16x8 a0h = *(const bf16x8*)(wa), a0l = *(const bf16x8*)(wa + RHL);
          const bf16x8 a1h = *(const bf16x8*)(wa + 32 * RPW), a1l = *(const bf16x8*)(wa + RHL + 32 * RPW);
          acc0 = __builtin_amdgcn_mfma_f32_32x32x16_bf16(a0h, yh, acc0, 0, 0, 0);
          acc0 = __builtin_amdgcn_mfma_f32_32x32x16_bf16(a0h, yl, acc0, 0, 0, 0);
          acc0 = __builtin_amdgcn_mfma_f32_32x32x16_bf16(a0l, yh, acc0, 0, 0, 0);
          acc1 = __builtin_amdgcn_mfma_f32_32x32x16_bf16(a1h, yh, acc1, 0, 0, 0);
          acc1 = __builtin_amdgcn_mfma_f32_32x32x16_bf16(a1h, yl, acc1, 0, 0, 0);
          acc1 = __builtin_amdgcn_mfma_f32_32x32x16_bf16(a1l, yh, acc1, 0, 0, 0);
        }
#pragma unroll
        for (int i = 0; i < 2; ++i) { const int xr_ = 16 * i + (lane >> 2), xg_ = lane & 3; const u32x4 xv_ = *(const u32x4*)(xs_ + xr_ * 80 + xg_ * 16);
          *(u32x4*)(XN2 + (size_t)(tb * 256 + wave * 32 + xr_) * DM + c * 64 + xg_ * 16) = xv_; }
#pragma unroll
        for (int i = 0; i < 8; ++i) *(f32x4*)(hw_ + 4 * i * HPW) = HQ_F32(hq[half ^ 1][i]);
        if (c + 1 < 16) { char* wn = lds + (half ^ 1) * RBUF; *(bf16x8*)(wn + wrow * RPW + wg * 16) = wsh; *(bf16x8*)(wn + RHL + wrow * RPW + wg * 16) = wsl; }
        { const int c2 = c + 2 < 16 ? c + 2 : 15; wsh = *(const bf16x8*)(WRh + (size_t)wrow * DM + c2 * 64 + wg * 8); wsl = *(const bf16x8*)(WRl + (size_t)wrow * DM + c2 * 64 + wg * 8); }
        __syncthreads();
      }
    }
    ss += __shfl_xor(ss, 32);
    const float rs = rsqrtf(ss * (1.f / DM) + EPS);
    float gl[4];
#pragma unroll
    for (int j = 0; j < 4; ++j) gl[j] = __shfl(acc1[j] * rs + p.b_group[j], r32);
    int gi = 0; float gm = gl[0];
    if (gl[1] > gm) { gm = gl[1]; gi = 1; } if (gl[2] > gm) { gm = gl[2]; gi = 2; } if (gl[3] > gm) { gm = gl[3]; gi = 3; }
    const float gw = 1.f / (__expf(gl[0] - gm) + __expf(gl[1] - gm) + __expf(gl[2] - gm) + __expf(gl[3] - gm));
    float l8[8];
#pragma unroll
    for (int j = 0; j < 4; ++j) { const float v = gi == 0 ? acc0[j] : (gi == 1 ? acc0[4 + j] : (gi == 2 ? acc0[8 + j] : acc0[12 + j]));
      const float mine = v * rs + p.b_router[gi * 8 + hi * 4 + j]; const float oth = __shfl_xor(mine, 32);
      l8[j] = hi ? oth : mine; l8[4 + j] = hi ? mine : oth; }
    float l1 = l8[0], l2 = l8[1]; int e1 = 0, e2 = 1;
    if (l2 > l1) { const float t_ = l1; l1 = l2; l2 = t_; e1 = 1; e2 = 0; }
#pragma unroll
    for (int j = 2; j < 8; ++j) { const float lv = l8[j];
      if (lv > l1) { l2 = l1; e2 = e1; l1 = lv; e1 = j; } else if (lv > l2) { l2 = lv; e2 = j; } }
    const float w1 = 1.f / (1.f + __expf(l2 - l1)), w2 = 1.f - w1;
    const int ea = e1 < e2 ? e1 : e2, eb = e1 < e2 ? e2 : e1;
    const float ga = gw * (e1 < e2 ? w1 : w2), gb = gw * (e1 < e2 ? w2 : w1);
    const int bucket = gi * 28 + (ea * 7 - (ea * (ea - 1)) / 2 + (eb - ea - 1));
    unsigned* lc = (unsigned*)(lds + O_G + 4096); unsigned* lbase = lc + 128;
    if (tid < NBUCKET) lc[tid] = 0u;
    __syncthreads();
    unsigned rank = 0u;
    if (hi == 0) { rank = atomicAdd(&lc[bucket], 1u); *(f32x4*)(gate + 4 * (size_t)tok) = (f32x4){ga, gb, rs, 0.f}; }
    __syncthreads();
    if (tid < NBUCKET) { const unsigned c_ = lc[tid]; lbase[tid] = c_ ? atomicAdd(&cnt[tid], c_) : 0u; }
    __syncthreads();
    if (hi == 0) list[(size_t)bucket * T + lbase[bucket] + rank] = tok;
  }
}

__device__ __forceinline__ void build_tile_table(const Params& p, char* lds) {
  unsigned* tab = (unsigned*)(lds + LDS_TAB);
  const unsigned* cnt = (const unsigned*)(p.ws + WS_CNT);
  unsigned* lcnt = tab + 512; unsigned* lnt = tab + 640;
  if (threadIdx.x < NBUCKET) { const unsigned c = cnt[threadIdx.x]; lcnt[threadIdx.x] = c; lnt[threadIdx.x] = (c + 255u) >> 8; }
  __syncthreads();
  if (threadIdx.x < NBUCKET) {
    int off = 0;
    for (int b = 0; b < (int)threadIdx.x; ++b) off += (int)lnt[b];
    const int n = (int)lnt[threadIdx.x];
    for (int j = 0; j < n; ++j) if (off + j < MAXTILES) tab[1 + off + j] = (unsigned)threadIdx.x | ((unsigned)(j * 256) << 8);
    if (threadIdx.x == NBUCKET - 1) tab[0] = (unsigned)(off + n < MAXTILES ? off + n : MAXTILES);
  }
  __syncthreads();
}
__device__ __forceinline__ void bucket_experts(int bucket, int& ea, int& eb) {
  const int grp = bucket / 28; int pi = bucket % 28; int a = 0;
  while (pi >= 7 - a) { pi -= 7 - a; ++a; }
  ea = grp * 8 + a; eb = grp * 8 + a + 1 + pi;
}

__device__ __forceinline__ void phase_gather(const Params& p, char* lds) {
  const int tid = otid(), lane = tid & 63, wave = tid >> 6;
  unsigned char* ws = p.ws;
  const unsigned* tab = (const unsigned*)(lds + LDS_TAB);
  const unsigned* cnt = (const unsigned*)(ws + WS_CNT);
  const int* list = (const int*)(ws + WS_LIST);
  const float* gate = (const float*)(ws + WS_GATE);
  const unsigned char* XN2 = (const unsigned char*)(ws + WS_R1);
  unsigned char* Xg8 = (unsigned char*)(ws + WS_R2);
  int* stok = (int*)(ws + WS_SLOT); float* sga = (float*)(stok + MAXSLOTS); float* sgb = sga + MAXSLOTS; float* srs = sgb + MAXSLOTS;
  const int ntile = (int)tab[0];
  for (int rowi = blockIdx.x * 512 + tid; rowi < ntile * 256; rowi += gridDim.x * 512) {
    const int tile = rowi >> 8, r = rowi & 255; const unsigned te = tab[1 + tile]; const int bk = te & 255, first = te >> 8;
    const int idx = first + r; const int tok = idx < (int)tab[512 + bk] ? list[(size_t)bk * T + idx] : -1;
    const f32x4 gt = tok >= 0 ? *(const f32x4*)(gate + 4 * (size_t)tok) : (f32x4){0.f, 0.f, 0.f, 0.f}; stok[rowi] = tok; sga[rowi] = gt.x; sgb[rowi] = gt.y; srs[rowi] = gt.z * (1.f / WGU_SCALE);
  }
  const int gw = blockIdx.x * 8 + wave, NGW = gridDim.x * 8, nrow = ntile * 256;
  for (int r0 = gw; r0 < nrow; r0 += 8 * NGW) {
    int tk[8];
#pragma unroll
    for (int q = 0; q < 8; ++q) { const int rowi = r0 + q * NGW; tk[q] = -1;
      if (rowi < nrow) { const int tile = rowi >> 8, r = rowi & 255; const unsigned te = tab[1 + tile]; const int bk = te & 255, first = te >> 8; const int idx = first + r;
        if (idx < (int)tab[512 + bk]) tk[q] = list[(size_t)bk * T + idx]; } }
    u32x4 v[8];
#pragma unroll
    for (int q = 0; q < 8; ++q) v[q] = tk[q] >= 0 ? ((const u32x4*)(XN2 + (size_t)tk[q] * DM))[lane] : (u32x4){0u, 0u, 0u, 0u};
#pragma unroll
    for (int q = 0; q < 8; ++q) { const int rowi = r0 + q * NGW; if (rowi < nrow) ((u32x4*)(Xg8 + (size_t)rowi * DM))[lane] = v[q]; }
  }
}

struct MoeOrderGU {
  static constexpr bool GATHER = false; static constexpr bool FP8 = true;
  const char* ldsb; const char* wsb; const int* stok; const char* Wgu; int G, c;
  __device__ unsigned row_off(const pg8::Unit& u, int row) const { const int tok = stok[u.pm * 256 + row]; return tok >= 0 ? (unsigned)(WS_R1 + (size_t)tok * (DM * 2)) : (unsigned)WS_ZROW; }
  __device__ bool next(int i, pg8::Unit& u) const {
    int toff = LDS_TAB; asm volatile("" : "+v"(toff)); const unsigned* tab = (const unsigned*)(ldsb + toff);
    const int L = i * G + c, tile = L >> 2, sub = L & 3; if (tile >= __builtin_amdgcn_readfirstlane((int)tab[0])) return false;
    int ea, eb; bucket_experts(__builtin_amdgcn_readfirstlane((int)(tab[1 + tile] & 255u)), ea, eb);
    const int e = (sub >> 1) ? eb : ea, hh = sub & 1;
    u.pm = tile; u.pn = sub; u.fin = 1; u.A = wsb + WS_R2 + (size_t)tile * 256 * DM; u.B0 = Wgu + ((size_t)e * 512 + hh * 256) * DM; return true;
  }
};
struct EpiGU {
  static constexpr bool PERM = true;
  unsigned char* H; const float* sga; const float* sgb; const float* srs;
  __device__ __forceinline__ void operator()(const f32x4 (&acc)[2][2][4][2], const pg8::Unit& u, int wr, int wc, int fr, int fq) const {
    const int which = u.pn >> 1, hh = u.pn & 1; const float* sg = which ? sgb : sga;
    const int row0 = u.pm * 256 + wr * 64 + fr, col0 = which * 256 + hh * 128 + wc * 32 + 8 * fq;
    float gwv[2][4], rsv[2][4];
#pragma unroll
    for (int ai = 0; ai < 2; ++ai)
#pragma unroll
      for (int m = 0; m < 4; ++m) { const int row = row0 + ai * 128 + m * 16; gwv[ai][m] = sg[row]; rsv[ai][m] = srs[row]; }
    asm volatile("" ::: "memory");
#pragma unroll
    for (int ai = 0; ai < 2; ++ai)
#pragma unroll
      for (int m = 0; m < 4; ++m) { const int row = row0 + ai * 128 + m * 16; const float gw = gwv[ai][m], rsr = rsv[ai][m];
        float hv[8];
#pragma unroll
        for (int n = 0; n < 2; ++n)
#pragma unroll
          for (int j = 0; j < 4; ++j) { const float gt = acc[ai][0][m][n][j] * rsr, up = acc[ai][1][m][n][j] * rsr; hv[4 * n + j] = gt * sigmoidf_(gt) * up * (gw * H_SCALE); }
        u32x2 w; w.x = pk4_fp8(hv[0], hv[1], hv[2], hv[3]); w.y = pk4_fp8(hv[4], hv[5], hv[6], hv[7]);
        *(u32x2*)(H + (size_t)row * 512 + col0) = w; }
  }
};
struct MoeOrderD {
  static constexpr bool GATHER = false; static constexpr bool FP8 = true;
  __device__ unsigned row_off(const pg8::Unit&, int) const { return 0u; }
  const char* ldsb; const char* Hb; const char* Wd; int G, c;
  __device__ bool next(int i, pg8::Unit& u) const {
    int toff = LDS_TAB; asm volatile("" : "+v"(toff)); const unsigned* tab = (const unsigned*)(ldsb + toff);
    const int P = (i >> 1) * G + c, part = i & 1, tile = P >> 2, pn = P & 3; if (tile >= __builtin_amdgcn_readfirstlane((int)tab[0])) return false;
    int ea, eb; bucket_experts(__builtin_amdgcn_readfirstlane((int)(tab[1 + tile] & 255u)), ea, eb);
    const int e = part ? eb : ea;
    u.pm = tile; u.pn = pn; u.fin = part; u.A = Hb + ((size_t)tile * 256 * 512 + part * 256); u.B0 = Wd + ((size_t)e * DM + pn * 256) * DEXP; return true;
  }
};
struct EpiDown {
  static constexpr bool PERM = true;
  float* out; const bf16_t* h16; const int* stok;
  __device__ __forceinline__ void operator()(const f32x4 (&acc)[2][2][4][2], const pg8::Unit& u, int wr, int wc, int fr, int fq) const {
    const int row0 = u.pm * 256 + wr * 64 + fr, col0 = u.pn * 256 + wc * 32 + 8 * fq;
    int tk2[2][4];
#pragma unroll
    for (int ai = 0; ai < 2; ++ai)
#pragma unroll
      for (int m = 0; m < 4; ++m) tk2[ai][m] = stok[row0 + ai * 128 + m * 16];
    u32x4 qv[2][4][2];
#pragma unroll
    for (int ai = 0; ai < 2; ++ai)
#pragma unroll
      for (int m = 0; m < 4; ++m) { const bf16_t* o = h16 + (size_t)(tk2[ai][m] >= 0 ? tk2[ai][m] : 0) * DM + col0;
#pragma unroll
        for (int bj = 0; bj < 2; ++bj) qv[ai][m][bj] = *(const u32x4*)(o + bj * 128); }
    asm volatile("" ::: "memory");
#pragma unroll
    for (int ai = 0; ai < 2; ++ai)
#pragma unroll
      for (int m = 0; m < 4; ++m) if (tk2[ai][m] >= 0) { float* o = out + (size_t)tk2[ai][m] * DM + col0;
#pragma unroll
        for (int bj = 0; bj < 2; ++bj) { const u32x4 q_ = qv[ai][m][bj];
          *(f32x4*)(o + bj * 128) = (f32x4){bflo(q_.x), bfhi(q_.x), bflo(q_.y), bfhi(q_.y)} + acc[ai][bj][m][0] * (1.f / (WD_SCALE * H_SCALE));
          *(f32x4*)(o + bj * 128 + 4) = (f32x4){bflo(q_.z), bfhi(q_.z), bflo(q_.w), bfhi(q_.w)} + acc[ai][bj][m][1] * (1.f / (WD_SCALE * H_SCALE)); } }
  }
};


#define XB_TMO      128
#define XB_XCNT(j)  (256  + 64 * (j))
#define XB_XSUB(j)  (1280 + 64 * (j))
#define XB_XGEN(j)  (2304 + 64 * (j))
#define XB_TOP      3328
#define XB_TOPGEN   3392
#define XCD_BAR_WORDS 3456
#define XB_SPIN_CAP (1u << 22)
__device__ __forceinline__ unsigned xb_ld(unsigned* p)              { return __hip_atomic_load(p, __ATOMIC_RELAXED, __HIP_MEMORY_SCOPE_AGENT); }
__device__ __forceinline__ unsigned xb_add(unsigned* p, unsigned v) { return __hip_atomic_fetch_add(p, v, __ATOMIC_RELAXED, __HIP_MEMORY_SCOPE_AGENT); }
__device__ __forceinline__ unsigned xb_xcc_id() { return (unsigned)__builtin_amdgcn_s_getreg((3 << 11) | 20) & 0xFu; }
#define XB_SPIN(cond, bar) do { unsigned _sp = 0; while (cond) { __builtin_amdgcn_s_sleep(1); \
    if ((++_sp & 255u) == 0u) { if (xb_ld(&(bar)[XB_TMO])) break; if (_sp > XB_SPIN_CAP) { atomicAdd(&(bar)[XB_TMO], 1u); break; } } } } while (0)
struct XcdBarrier { unsigned* bar; unsigned x; volatile LAS unsigned* st; };
__device__ __forceinline__ XcdBarrier xcd_barrier_post(unsigned* bar, volatile LAS unsigned* st) {
    XcdBarrier b; b.bar = bar; b.x = xb_xcc_id(); b.st = st;
    if (threadIdx.x == 0) (void)xb_add(&bar[XB_XCNT(b.x)], 1u);
    return b;
}
__device__ __forceinline__ void xcd_barrier_complete(unsigned* bar, unsigned x, unsigned& nloc, unsigned& nx) {
    const unsigned G = gridDim.x * gridDim.y * gridDim.z;
    unsigned sum, cnt, mine, sp = 0u;
    for (;;) {
        sum = 0u; cnt = 0u; mine = 0u;
#pragma unroll
        for (unsigned j = 0; j < 16; ++j) { const unsigned c = xb_ld(&bar[XB_XCNT(j)]); sum += c; cnt += (c > 0u) ? 1u : 0u; mine = (j == x) ? c : mine; }
        if (sum == G) break;
        __builtin_amdgcn_s_sleep(1);
        if ((++sp & 255u) == 0u) { if (xb_ld(&bar[XB_TMO])) break; if (sp > XB_SPIN_CAP) { atomicAdd(&bar[XB_TMO], 1u); break; } }
    }
    nloc = mine > 0u ? mine : 1u; nx = cnt > 0u ? cnt : 1u;
}
__device__ __forceinline__ void xcd_barrier(const XcdBarrier& b) {
    asm volatile("s_waitcnt vmcnt(0)" ::: "memory");
    __syncthreads();
    if (threadIdx.x == 0) {
        unsigned* bar = b.bar;
        __builtin_amdgcn_s_waitcnt(0);
        unsigned nloc = b.st[0], nx = b.st[1];
        if (nloc == 0u) { xcd_barrier_complete(bar, b.x, nloc, nx); b.st[0] = nloc; b.st[1] = nx; }
        const unsigned old = xb_add(&bar[XB_XSUB(b.x)], 1u);
        const unsigned gen = old / nloc;
        if (old + 1u == (gen + 1u) * nloc) {
            __builtin_amdgcn_fence(__ATOMIC_RELEASE, "agent");
            asm volatile("s_waitcnt vmcnt(0)" ::: "memory");
            const unsigned og = xb_add(&bar[XB_TOP], 1u);
            const unsigned tg = og / nx;
            if (og + 1u == (tg + 1u) * nx) xb_add(&bar[XB_TOPGEN], 1u);
            else XB_SPIN(xb_ld(&bar[XB_TOPGEN]) == tg, bar);
            __builtin_amdgcn_fence(__ATOMIC_ACQUIRE, "agent");
            xb_add(&bar[XB_XGEN(b.x)], 1u);
            asm volatile("s_waitcnt vmcnt(0)" ::: "memory");
        } else {
            XB_SPIN(xb_ld(&bar[XB_XGEN(b.x)]) == gen, bar);
            __builtin_amdgcn_fence(__ATOMIC_ACQUIRE, "agent");
            asm volatile("s_waitcnt vmcnt(0)" ::: "memory");
        }
    }
    __syncthreads();
}
#define XB_AX(k, j) (4096 + 1024 * (k) + 64 * (j))
#define XB_ATOP(k)  (6144 + 64 * (k))
__device__ __forceinline__ void xcd_arrive(const XcdBarrier& b, int k) {
    asm volatile("s_waitcnt vmcnt(0)" ::: "memory");
    __syncthreads();
    if (threadIdx.x == 0) {
        __builtin_amdgcn_s_waitcnt(0);
        const unsigned nloc = b.st[0];
        const unsigned old = xb_add(&b.bar[XB_AX(k, b.x)], 1u);
        if (old + 1u == nloc) { __builtin_amdgcn_fence(__ATOMIC_RELEASE, "agent"); asm volatile("s_waitcnt vmcnt(0)" ::: "memory"); xb_add(&b.bar[XB_ATOP(k)], 1u); }
    }
}
__device__ __forceinline__ void xcd_wait(const XcdBarrier& b, int k) {
    if (threadIdx.x == 0) {
        const unsigned nx = b.st[1];
        XB_SPIN(xb_ld(&b.bar[XB_ATOP(k)]) < nx, b.bar);
        __builtin_amdgcn_fence(__ATOMIC_ACQUIRE, "agent");
        asm volatile("s_waitcnt vmcnt(0)" ::: "memory");
    }
    __syncthreads();
}

__global__ void __launch_bounds__(512, 2) fwd_megakernel(Params p) {
  extern __shared__ __attribute__((aligned(16))) char lds[];
  cg::grid_group grid = cg::this_grid();
  unsigned char* ws = p.ws;
  LAS unsigned char* lds3 = (LAS unsigned char*)lds;
  const int G = gridDim.x, c = blockIdx.x;
  if (threadIdx.x < 2) ((volatile LAS unsigned*)(lds3 + LDS_BARST))[threadIdx.x] = 0u;
  __syncthreads();
  const XcdBarrier xbar = xcd_barrier_post((unsigned*)(ws + WS_BAR), (volatile LAS unsigned*)(lds3 + LDS_BARST));
#define GRID_BAR() xcd_barrier(xbar)

  phase_prep(p, lds);
  if (p.ws == nullptr) grid.sync();
  GRID_BAR();
  { pg8::Gemm g{DM, DM, DM}; pg8::StaticOrder S; S.init(ws + WS_R1, ws + WS_WIN, T, NP, DM, DM, G, c);
    pg8::EpiBf16 E{(bf16_t*)(ws + WS_R2), NP, (const float*)(ws + WS_OML)};
    pg8::gemm_phase<pg8::EpiBf16, pg8::StaticOrder>(lds3, g, S, E); }
  GRID_BAR();
#if ENABLE_ATTN
  phase_mla_prep(p, lds);
#endif
  xcd_arrive(xbar, 0);
#if ENABLE_HGRN
  phase_hgrn_fused(p, lds);
#endif
  xcd_arrive(xbar, 1);
  xcd_wait(xbar, 0);
#if ENABLE_ATTN
  bool fin_done = false;
  { const int j_ = blockIdx.x >> 3, nj_ = gridDim.x >> 3;
#pragma unroll 1
    for (int it = 0, u_ = j_; u_ < 8 * (SEQ / 512); u_ += nj_, ++it) {
      phase_attention(p, lds, u_);
      if (it == (j_ & 3)) { xcd_wait(xbar, 1); phase_hgrn_final(p); fin_done = true; }
    } }
#else
  for (size_t i = (size_t)blockIdx.x * 512 + threadIdx.x; i < (size_t)T * 64; i += (size_t)gridDim.x * 512) { const size_t m = i >> 6, cc = i & 63; ((u32x4*)(ws + WS_R4 + m * 2048))[cc] = (u32x4){0u, 0u, 0u, 0u}; }
#endif
#if ENABLE_HGRN && ENABLE_ATTN
  if (!fin_done) { xcd_wait(xbar, 1); phase_hgrn_final(p); }
#elif ENABLE_HGRN
  xcd_wait(xbar, 1);
  phase_hgrn_final(p);
#else
  for (size_t i = (size_t)blockIdx.x * 512 + threadIdx.x; i < (size_t)T * 64; i += (size_t)gridDim.x * 512) { const size_t m = i >> 6, cc = i & 63; ((u32x4*)(ws + WS_R4 + m * 2048 + 1024))[cc] = (u32x4){0u, 0u, 0u, 0u}; }
#endif
  GRID_BAR();
  { pg8::Gemm g{DM, DM, DM}; pg8::StaticOrder S; S.init(ws + WS_R4, ws + WS_WOUT, T, DM, DM, DM, G, c);
    pg8::EpiResid E{(const bf16_t*)(ws + WS_R1), (const float*)(ws + WS_LIST), (bf16_t*)(ws + WS_H16)};
    pg8::gemm_phase<pg8::EpiResid, pg8::StaticOrder>(lds3, g, S, E); }
#if ENABLE_MOE
  GRID_BAR();
  phase_router(p, lds);
  GRID_BAR();
  build_tile_table(p, lds);
  phase_gather(p, lds);
  GRID_BAR();
  { pg8::Gemm g{DM / 2, DM / 2, DM / 2}; MoeOrderGU S{(const char*)lds, (const char*)ws, (const int*)(ws + WS_SLOT), (const char*)(ws + WS_WGU), G, c};
    EpiGU E{(unsigned char*)(ws + WS_R3), (const float*)(ws + WS_SLOT) + MAXSLOTS, (const float*)(ws + WS_SLOT) + 2 * MAXSLOTS, (const float*)(ws + WS_SLOT) + 3 * MAXSLOTS};
    pg8::gemm_phase<EpiGU, MoeOrderGU>(lds3, g, S, E); }
  GRID_BAR();
  { pg8::Gemm g{DEXP / 2, 512 / 2, DEXP / 2}; MoeOrderD S{(const char*)lds, (const char*)(ws + WS_R3), (const char*)(ws + WS_WD), G, c};
    EpiDown E{p.out, (const bf16_t*)(ws + WS_H16), (const int*)(ws + WS_SLOT)};
    pg8::gemm_phase<EpiDown, MoeOrderD>(lds3, g, S, E); }
#endif
}

extern "C" void kernel_launch(void* const* d_in, const int* in_sizes, int n_in, void* d_out, int out_size,
                              void* d_ws, size_t ws_size, hipStream_t stream) {
  static int grid_blocks = 0;
  if (grid_blocks == 0) {
    if (n_in != 20 || in_sizes[0] != T * DM || out_size != T * DM || ws_size < WS_END) {
      fprintf(stderr, "kernel_launch: unexpected shapes: n_in %d in0 %d out %d ws %zu (need %zu)\n", n_in, n_in > 0 ? in_sizes[0] : -1, out_size, ws_size, (size_t)WS_END); grid_blocks = -1; return; }
    int dev = 0, cus = 0, per_cu = 0;
    (void)hipGetDevice(&dev);
    (void)hipDeviceGetAttribute(&cus, hipDeviceAttributeMultiprocessorCount, dev);
    if (hipFuncSetAttribute((const void*)fwd_megakernel, hipFuncAttributeMaxDynamicSharedMemorySize, LDS_BYTES) != hipSuccess) { fprintf(stderr, "kernel_launch: hipFuncSetAttribute failed\n"); grid_blocks = -1; return; }
    (void)hipOccupancyMaxActiveBlocksPerMultiprocessor(&per_cu, (const void*)fwd_megakernel, 512, LDS_BYTES);
    fprintf(stderr, "kernel_launch: cus %d per_cu %d ws %zu\n", cus, per_cu, ws_size);
    if (per_cu < 1) { grid_blocks = -1; return; }
    grid_blocks = cus;
    if (grid_blocks % 8) grid_blocks -= grid_blocks % 8;
  }
  if (grid_blocks < 0) return;
  if (hipMemsetAsync(d_ws, 0, 1 * MiB, stream) != hipSuccess) { fprintf(stderr, "kernel_launch: memset failed\n"); return; }
  Params p{};
  const float** pf = (const float**)&p;
  for (int i = 0; i < 20; ++i) pf[i] = (const float*)d_in[i];
  p.out = (float*)d_out; p.ws = (unsigned char*)d_ws;
  void* args[] = {&p};
  hipError_t e = hipLaunchCooperativeKernel((void*)fwd_megakernel, dim3(grid_blocks), dim3(512), args, LDS_BYTES, stream);
  if (e != hipSuccess) fprintf(stderr, "cooperative launch failed: %s (grid %d)\n", hipGetErrorString(e), grid_blocks);
}
```
